# Optimizing an MI355X kernel written in HIP

```python
import math
import jax, jax.numpy as jnp
from jax import lax
import numpy as np

D_MODEL = 1024
BATCH = 8
SEQ = 4096
DEPTH = 2

D_FF = 2816
HEAD_DIM = 64
W_A = 256
A_BLOCKS = 4
A_BLOCK_W = W_A // A_BLOCKS
LRU_C = 8.0
LRU_CONV = 4
N_Q_HEADS = 8
N_KV_HEADS = 2
W_B = N_Q_HEADS * HEAD_DIM
WINDOW = 128
BLK = 128
W_C = 256
C_GROUPS = 4
C_CONV = 31
D_MIX = W_A + W_B + W_C
OFF_LRU_X = 0
OFF_LRU_GATE = OFF_LRU_X + W_A
OFF_Q = OFF_LRU_GATE + W_A
OFF_K = OFF_Q + W_B
OFF_V = OFF_K + N_KV_HEADS * HEAD_DIM
OFF_GLU = OFF_V + N_KV_HEADS * HEAD_DIM
D_IN_PROJ = OFF_GLU + 2 * W_C
NORM_EPS = 1e-6
LN_EPS = 1e-5
NEG_BIG = -1e30

kernel_name = "hymba_style_lru_swa_conformer_macaron"


def rms_norm(x, g):
    xf = x.astype(jnp.float32)
    y = xf * lax.rsqrt(jnp.mean(xf * xf, axis=-1, keepdims=True) + NORM_EPS)
    return (y * g.astype(jnp.float32)).astype(x.dtype)


def layer_norm(x, g, b):
    xf = x.astype(jnp.float32)
    mu = jnp.mean(xf, axis=-1, keepdims=True)
    xc = xf - mu
    var = jnp.mean(xc * xc, axis=-1, keepdims=True)
    y = xc * lax.rsqrt(var + LN_EPS) * g.astype(jnp.float32) + b.astype(jnp.float32)
    return y.astype(x.dtype)


def swiglu(x, w_gu, w_down):
    g, u = jnp.split(x @ w_gu, 2, axis=-1)
    return (jax.nn.silu(g) * u) @ w_down


def causal_depthwise_conv(x, w, b):
    k = w.shape[0]
    y = lax.conv_general_dilated(
        x, w[:, None, :], window_strides=(1,), padding=[(k - 1, 0)],
        dimension_numbers=("NWC", "WIO", "NWC"), feature_group_count=x.shape[-1])
    return y + b


def rg_lru(x, w_a, b_a, w_x, b_x, lam):
    bsz, s, w = x.shape
    xb = x.reshape(bsz, s, A_BLOCKS, A_BLOCK_W)
    r = jax.nn.sigmoid(jnp.einsum("bshi,hij->bshj", xb, w_a).reshape(bsz, s, w) + b_a)
    i = jax.nn.sigmoid(jnp.einsum("bshi,hij->bshj", xb, w_x).reshape(bsz, s, w) + b_x)
    log_a = -LRU_C * r.astype(jnp.float32) * jax.nn.softplus(-lam.astype(jnp.float32))
    a = jnp.exp(log_a)
    u = jnp.sqrt(-jnp.expm1(2.0 * log_a)) * (i * x).astype(jnp.float32)

    def combine(left, right):
        a1, b1 = left
        a2, b2 = right
        return a1 * a2, a2 * b1 + b2

    _, h = lax.associative_scan(combine, (a, u), axis=1)
    return h.astype(x.dtype)


def sliding_window_attention_sinks(q, k, v, sinks):
    bsz, s, h, d = q.shape
    kvh = k.shape[2]
    grp = h // kvh
    nblk = s // BLK
    qb = q.reshape(bsz, nblk, BLK, kvh, grp, d)

    def banded(t):
        cur = t.reshape(bsz, nblk, BLK, kvh, d)
        prev = jnp.pad(t, ((0, 0), (BLK, 0), (0, 0), (0, 0)))[:, :s].reshape(bsz, nblk, BLK, kvh, d)
        return jnp.concatenate([prev, cur], axis=2)

    kw, vw = banded(k), banded(v)
    scores = jnp.einsum("bnqkgd,bnjkd->bnkgqj", qb, kw).astype(jnp.float32) * (1.0 / math.sqrt(d))
    qi = jnp.arange(BLK)[:, None]
    kj = jnp.arange(2 * BLK)[None, :]
    rel = BLK + qi - kj
    k_pos = (jnp.arange(nblk)[:, None, None] - 1) * BLK + kj[None]
    mask = (rel >= 0)[None] & (rel < WINDOW)[None] & (k_pos >= 0)
    scores = jnp.where(mask[None, :, None, None], scores, NEG_BIG)
    sink = sinks.astype(jnp.float32).reshape(1, 1, kvh, grp, 1, 1)
    m = jnp.maximum(jnp.max(scores, axis=-1, keepdims=True), sink)
    p = jnp.exp(scores - m)
    p = p / (jnp.sum(p, axis=-1, keepdims=True) + jnp.exp(sink - m))
    o = jnp.einsum("bnkgqj,bnjkd->bnqkgd", p.astype(v.dtype), vw)
    return o.reshape(bsz, s, h * d)


def conformer_conv(glu_in, w, b, ln_g, ln_b):
    a, g = jnp.split(glu_in, 2, axis=-1)
    y = a * jax.nn.sigmoid(g)
    y = causal_depthwise_conv(y, w, b)
    y = layer_norm(y, ln_g, ln_b)
    return jax.nn.silu(y)


def setup_inputs(seed: int = 0) -> dict:
    key = jax.random.key(seed)
    ks = iter(jax.random.split(key, 40))
    L = DEPTH

    def nrm(shape, scale):
        return scale * jax.random.normal(next(ks), shape, jnp.float32)

    def gain(shape):
        return 1.0 + 0.05 * jax.random.normal(next(ks), shape, jnp.float32)

    a0 = jax.random.uniform(next(ks), (L, W_A), jnp.float32, minval=0.9, maxval=0.999)
    return {
        "x": jax.random.normal(next(ks), (BATCH, SEQ, D_MODEL), jnp.float32),
        "ffn1_pre_g": gain((L, D_MODEL)),
        "ffn1_w_gu": nrm((L, D_MODEL, 2 * D_FF), D_MODEL ** -0.5),
        "ffn1_w_down": nrm((L, D_FF, D_MODEL), D_FF ** -0.5),
        "ffn1_post_g": gain((L, D_MODEL)),
        "mix_pre_g": gain((L, D_MODEL)),
        "w_in": nrm((L, D_MODEL, D_IN_PROJ), D_MODEL ** -0.5),
        "lru_conv_w": nrm((L, LRU_CONV, W_A), LRU_CONV ** -0.5),
        "lru_conv_b": nrm((L, W_A), 0.02),
        "lru_w_a": nrm((L, A_BLOCKS, A_BLOCK_W, A_BLOCK_W), A_BLOCK_W ** -0.5),
        "lru_b_a": nrm((L, W_A), 0.02),
        "lru_w_x": nrm((L, A_BLOCKS, A_BLOCK_W, A_BLOCK_W), A_BLOCK_W ** -0.5),
        "lru_b_x": nrm((L, W_A), 0.02),
        "lru_lambda": jnp.log(a0) - jnp.log1p(-a0),
        "attn_sinks": nrm((L, N_Q_HEADS), 0.5),
        "conv_w": nrm((L, C_CONV, W_C), C_CONV ** -0.5),
        "conv_b": nrm((L, W_C), 0.02),
        "conv_ln_g": gain((L, W_C)),
        "conv_ln_b": nrm((L, W_C), 0.02),
        "group_g": gain((L, D_MIX)),
        "w_out": nrm((L, D_MIX, D_MODEL), D_MIX ** -0.5),
        "mix_post_g": gain((L, D_MODEL)),
        "ffn2_pre_g": gain((L, D_MODEL)),
        "ffn2_w_gu": nrm((L, D_MODEL, 2 * D_FF), D_MODEL ** -0.5),
        "ffn2_w_down": nrm((L, D_FF, D_MODEL), D_FF ** -0.5),
        "ffn2_post_g": gain((L, D_MODEL)),
    }


def reference(x, ffn1_pre_g, ffn1_w_gu, ffn1_w_down, ffn1_post_g, mix_pre_g, w_in,
              lru_conv_w, lru_conv_b, lru_w_a, lru_b_a, lru_w_x, lru_b_x, lru_lambda,
              attn_sinks, conv_w, conv_b, conv_ln_g, conv_ln_b, group_g, w_out,
              mix_post_g, ffn2_pre_g, ffn2_w_gu, ffn2_w_down, ffn2_post_g):
    bsz, s, _ = x.shape
    for l in range(DEPTH):
        x = x + 0.5 * rms_norm(swiglu(rms_norm(x, ffn1_pre_g[l]), ffn1_w_gu[l], ffn1_w_down[l]), ffn1_post_g[l])

        hn = rms_norm(x, mix_pre_g[l])
        proj = hn @ w_in[l]
        lru_x = proj[..., OFF_LRU_X:OFF_LRU_GATE]
        lru_gate = proj[..., OFF_LRU_GATE:OFF_Q]
        q = proj[..., OFF_Q:OFF_K].reshape(bsz, s, N_Q_HEADS, HEAD_DIM)
        k = proj[..., OFF_K:OFF_V].reshape(bsz, s, N_KV_HEADS, HEAD_DIM)
        v = proj[..., OFF_V:OFF_GLU].reshape(bsz, s, N_KV_HEADS, HEAD_DIM)
        glu_in = proj[..., OFF_GLU:]

        y_a = jax.nn.gelu(lru_gate) * rg_lru(
            causal_depthwise_conv(lru_x, lru_conv_w[l], lru_conv_b[l]),
            lru_w_a[l], lru_b_a[l], lru_w_x[l], lru_b_x[l], lru_lambda[l])
        y_b = sliding_window_attention_sinks(q, k, v, attn_sinks[l])
        y_c = conformer_conv(glu_in, conv_w[l], conv_b[l], conv_ln_g[l], conv_ln_b[l])

        gg = group_g[l]
        y = jnp.concatenate([
            rms_norm(y_a, gg[:W_A]),
            rms_norm(y_b, gg[W_A:W_A + W_B]),
            rms_norm(y_c, gg[W_A + W_B:]),
        ], axis=-1)
        x = x + rms_norm(y @ w_out[l], mix_post_g[l])

        x = x + 0.5 * rms_norm(swiglu(rms_norm(x, ffn2_pre_g[l]), ffn2_w_gu[l], ffn2_w_down[l]), ffn2_post_g[l])
    return x
```

```cpp
#include <hip/hip_runtime.h>
#include <hip/hip_cooperative_groups.h>
#include <cstdio>
#include <cstdint>
namespace cg = cooperative_groups;

__device__ __forceinline__ float xsum16(float x) { auto r = __builtin_amdgcn_permlane16_swap(__float_as_uint(x), __float_as_uint(x), false, false); return __uint_as_float(r[0]) + __uint_as_float(r[1]); }
__device__ __forceinline__ float xsum32(float x) { auto r = __builtin_amdgcn_permlane32_swap(__float_as_uint(x), __float_as_uint(x), false, false); return __uint_as_float(r[0]) + __uint_as_float(r[1]); }
__device__ __forceinline__ float xmax16(float x) { auto r = __builtin_amdgcn_permlane16_swap(__float_as_uint(x), __float_as_uint(x), false, false); return fmaxf(__uint_as_float(r[0]), __uint_as_float(r[1])); }
__device__ __forceinline__ float xmax32(float x) { auto r = __builtin_amdgcn_permlane32_swap(__float_as_uint(x), __float_as_uint(x), false, false); return fmaxf(__uint_as_float(r[0]), __uint_as_float(r[1])); }
namespace pg8 {
#define PG8_LAS __attribute__((address_space(3)))
typedef unsigned short bf16_t;
typedef short bf16x8 __attribute__((ext_vector_type(8)));
typedef float f32x4 __attribute__((ext_vector_type(4)));
typedef unsigned u32x4 __attribute__((ext_vector_type(4)));
constexpr int BM = 256, BK = 64, HALF = 128, HTB = HALF * BK * 2, STAGE_BYTES = 8 * HTB, NXCD = 8, WGM = 8;

__host__ __device__ __forceinline__ int lds_byte(int r, int c) { const int st = (r >> 4) * 2 + (c >> 5), rr = r & 15, cc = c & 31, ob = rr * 64 + cc * 2; return st * 1024 + (ob ^ (((ob >> 9) & 1) << 5)); }
__host__ __device__ __forceinline__ void stage_rc(int b, int& R, int& C) { const int st = b / 1024, sb = b % 1024, swz = sb ^ (((sb >> 9) & 1) << 5); R = (st >> 1) * 16 + swz / 64; C = (st & 1) * 32 + (swz % 64) / 2; }
__host__ __device__ __forceinline__ int perm32(int rho) { const int n = rho >> 4, i = rho & 15; return 8 * (i >> 2) + 4 * n + (i & 3); }

struct Unit { int pm, pn, par; };
struct Gemm { const bf16_t* A; const bf16_t* Bt; int M, N, K; };

struct StaticOrder {
    int nM, nN, nwg, G, c;
    __host__ __device__ void init(int M, int N, int G_, int c_) { nM = M / BM; nN = N / BM; nwg = nM * nN; G = G_; c = c_; }
    __host__ __device__ bool next(int i, Unit& u) const {
        const long L = (long)i * G + c; if (L >= nwg) return false;
        int wgid = (int)L; { const int q = nwg / NXCD, r = nwg % NXCD, xcd = wgid % NXCD, off = wgid / NXCD; wgid = (xcd < r ? xcd * (q + 1) : r * (q + 1) + (xcd - r) * q) + off; }
        const int nig = WGM * nN, gid = wgid / nig, fm = gid * WGM, gsz = (nM - fm) < WGM ? (nM - fm) : WGM;
        u.pm = fm + ((wgid % nig) % gsz); u.pn = (wgid % nig) / gsz; u.par = i & 1; return true;
    }
    __device__ __forceinline__ void a_ready(const Unit&) const {}
    __device__ __forceinline__ void done(const Unit&) const {}
};

struct StaticOrderRS : StaticOrder {
    const float* ssp; PG8_LAS unsigned char* tab;
    __device__ __forceinline__ void a_ready(const Unit& u) const {
        const int tid = threadIdx.x; const int wid = __builtin_amdgcn_readfirstlane(tid >> 6), lane = tid & 63;
        if (wid < 4) __builtin_amdgcn_global_load_lds((const unsigned*)(ssp + ((size_t)u.pm * BM + wid * 64 + lane) * 4), (PG8_LAS unsigned*)(tab + u.par * 4096 + wid * 1024), 16, 0, 0);
    }
};

__device__ __forceinline__ unsigned cvt_pk_bf16(float lo, float hi) { unsigned r; asm volatile("v_cvt_pk_bf16_f32 %0, %1, %2" : "=v"(r) : "v"(lo), "v"(hi)); return r; }

template <bool SCALE> struct EpiBf16T {
    static constexpr bool PERM = true, AFTER_DRAIN = false;
    bf16_t* O; int ldc; PG8_LAS unsigned char* rs;
    __device__ __forceinline__ void operator()(const f32x4 (&acc)[2][2][4][2], const Unit& u, int wr, int wc, int fr, int fq) const {
        const int row0 = u.pm * BM + wr * 64 + fr; const int col0 = u.pn * BM + wc * 32 + 8 * fq;
#pragma unroll
        for (int ai = 0; ai < 2; ++ai)
#pragma unroll
            for (int m = 0; m < 4; ++m) { const int row = row0 + ai * HALF + m * 16; bf16_t* rowp = O + (size_t)row * ldc + col0;
                float sc = 1.f; if (SCALE) { const f32x4 p4 = *(const PG8_LAS f32x4*)(rs + u.par * 4096 + (wr * 64 + fr + ai * HALF + m * 16) * 16); sc = rsqrtf(((p4[0] + p4[1]) + (p4[2] + p4[3])) * (1.f / 1024.f) + 1e-6f); }
#pragma unroll
                for (int bj = 0; bj < 2; ++bj) { const f32x4 v0 = acc[ai][bj][m][0] * sc, v1 = acc[ai][bj][m][1] * sc;
                    u32x4 w; w.x = cvt_pk_bf16(v0[0], v0[1]); w.y = cvt_pk_bf16(v0[2], v0[3]); w.z = cvt_pk_bf16(v1[0], v1[1]); w.w = cvt_pk_bf16(v1[2], v1[3]);
                    *(u32x4*)(rowp + bj * HALF) = w; } }
    }
};
typedef EpiBf16T<false> EpiBf16; typedef EpiBf16T<true> EpiBf16S;
typedef float f32x2 __attribute__((ext_vector_type(2)));
__device__ __forceinline__ float silu_mul(float g, float u) { return g * u * __builtin_amdgcn_rcpf(1.f + __expf(-g)); }
struct EpiSwiGLU {
    static constexpr bool PERM = true, AFTER_DRAIN = false;
    bf16_t* O; int ldc; PG8_LAS unsigned char* rs;
    __device__ __forceinline__ void operator()(const f32x4 (&acc)[2][2][4][2], const Unit& u, int wr, int wc, int fr, int fq) const {
        const int row0 = u.pm * BM + wr * 64 + fr; const int col0 = u.pn * HALF + wc * 32 + 8 * fq;
#pragma unroll
        for (int ai = 0; ai < 2; ++ai)
#pragma unroll
            for (int m = 0; m < 4; ++m) { const int row = row0 + ai * HALF + m * 16; bf16_t* rowp = O + (size_t)row * ldc + col0;
                const f32x4 p4 = *(const PG8_LAS f32x4*)(rs + u.par * 4096 + (wr * 64 + fr + ai * HALF + m * 16) * 16); const float sc = rsqrtf(((p4[0] + p4[1]) + (p4[2] + p4[3])) * (1.f / 1024.f) + 1e-6f);
                const float kk = -1.4426950408889634f * sc, sc2 = sc * sc;
                u32x4 w; unsigned wq[4];
#pragma unroll
                for (int q = 0; q < 4; ++q) { const int n = q >> 1, e0 = (q & 1) * 2;
                    const f32x2 gg = (f32x2){acc[ai][0][m][n][e0], acc[ai][0][m][n][e0 + 1]}, uu = (f32x2){acc[ai][1][m][n][e0], acc[ai][1][m][n][e0 + 1]};
                    const f32x2 t = gg * kk; f32x2 d; d.x = __builtin_amdgcn_exp2f(t.x); d.y = __builtin_amdgcn_exp2f(t.y); d = d + 1.0f;
                    f32x2 r; r.x = __builtin_amdgcn_rcpf(d.x); r.y = __builtin_amdgcn_rcpf(d.y);
                    const f32x2 o = ((gg * uu) * sc2) * r;
                    wq[q] = cvt_pk_bf16(o.x, o.y); }
                w.x = wq[0]; w.y = wq[1]; w.z = wq[2]; w.w = wq[3];
                *(u32x4*)rowp = w; }
    }
};


template <class Epi, class Sched, bool ALIGN_EPI = false, bool SP2 = false>
__device__ __forceinline__ void gemm_phase(PG8_LAS unsigned char* lds, const Gemm g, const Sched& S, const Epi& E) {
    int tid_ = threadIdx.x; asm volatile("" : "+v"(tid_));
    const int tid = tid_, wid = __builtin_amdgcn_readfirstlane(tid >> 6), lane = tid & 63, wr = wid >> 2, wc = wid & 3, fr = lane & 15, fq = lane >> 4;
    const int K = g.K, nt = K / BK;
    unsigned voffA[2], voffB[2];
#pragma unroll
    for (int i = 0; i < 2; ++i) { int R, C; stage_rc(tid * 16 + i * 8192, R, C); const int Rb = Epi::PERM ? ((R & ~31) + perm32(R & 31)) : R;
        voffA[i] = (unsigned)(R * K + C) * 2u; voffB[i] = (unsigned)(Rb * K + C) * 2u; }
    const size_t kstep = (size_t)(BK * 2);
    const size_t hstep = (size_t)HALF * K * 2;
    const size_t tstep = 2 * hstep;
    const unsigned ldsw = (unsigned)wid * 1024u;
    const int aoff = lds_byte(wr * 64 + fr, fq * 8), boff = lds_byte(wc * 32 + fr, fq * 8);
#define PG8_SA(b, h) (((b) * 2 + (h)) * HTB)
#define PG8_SB(b, h) ((4 + (b) * 2 + (h)) * HTB)
#define PG8_STAGE(bufoff, gbase, voff) do { _Pragma("unroll") for (int _i = 0; _i < 2; ++_i) \
        __builtin_amdgcn_global_load_lds((const unsigned*)((const char*)(gbase) + (voff)[_i]), (PG8_LAS unsigned*)(lds + (bufoff) + ldsw + _i * 8192), 16, 0, 0); } while (0)
#define PG8_LDA(dst, b, h) do { _Pragma("unroll") for (int m = 0; m < 4; ++m) _Pragma("unroll") for (int k = 0; k < 2; ++k) dst[m][k] = *(const PG8_LAS bf16x8*)(lds + PG8_SA(b, h) + aoff + m * 2048 + k * 1024); } while (0)
#define PG8_LDB(dst, b, h) do { _Pragma("unroll") for (int n = 0; n < 2; ++n) _Pragma("unroll") for (int k = 0; k < 2; ++k) dst[n][k] = *(const PG8_LAS bf16x8*)(lds + PG8_SB(b, h) + boff + n * 2048 + k * 1024); } while (0)
#define PG8_MMA(ai, bj, At, Bt) do { __builtin_amdgcn_s_setprio(1); _Pragma("unroll") for (int m = 0; m < 4; ++m) _Pragma("unroll") for (int n = 0; n < 2; ++n) _Pragma("unroll") for (int k = 0; k < 2; ++k) \
        acc[ai][bj][m][n] = __builtin_amdgcn_mfma_f32_16x16x32_bf16(Bt[n][k], At[m][k], acc[ai][bj][m][n], 0, 0, 0); __builtin_amdgcn_s_setprio(0); } while (0)
#define PG8_WAIT_V(n) asm volatile("s_waitcnt vmcnt(" #n ")" ::: "memory")
#define PG8_WAIT_L(n) asm volatile("s_waitcnt lgkmcnt(" #n ")" ::: "memory")
#define PG8_BAR __builtin_amdgcn_s_barrier()
#define PG8_SCHED __builtin_amdgcn_sched_barrier(0)
    Unit cur, nxt; int ui = 0;
    if (!S.next(0, cur)) return;
    f32x4 acc[2][2][4][2];
#pragma unroll
    for (int a = 0; a < 2; ++a)
#pragma unroll
        for (int b = 0; b < 2; ++b)
#pragma unroll
            for (int m = 0; m < 4; ++m)
#pragma unroll
                for (int n = 0; n < 2; ++n) acc[a][b][m][n] = (f32x4){0.f, 0.f, 0.f, 0.f};
    bf16x8 At[4][2], B0[2][2], B1[2][2];
    const char* cA = (const char*)g.A + (size_t)cur.pm * tstep; const char* cB = (const char*)g.Bt + (size_t)cur.pn * tstep;
    S.a_ready(cur);
    if constexpr (SP2) {
        PG8_STAGE(PG8_SB(0, 0), cB, voffB); PG8_STAGE(PG8_SB(0, 1), cB + hstep, voffB); PG8_STAGE(PG8_SA(0, 0), cA, voffA); PG8_STAGE(PG8_SA(0, 1), cA + hstep, voffA);
        if (wr == 1) PG8_BAR;
        PG8_WAIT_V(2); PG8_BAR;
        PG8_STAGE(PG8_SB(1, 0), cB + kstep, voffB); PG8_STAGE(PG8_SA(1, 0), cA + kstep, voffA); PG8_STAGE(PG8_SB(1, 1), cB + hstep + kstep, voffB);
        PG8_WAIT_V(6); PG8_BAR;
    } else {
        PG8_STAGE(PG8_SB(0, 0), cB, voffB); PG8_STAGE(PG8_SA(0, 0), cA, voffA); PG8_STAGE(PG8_SB(0, 1), cB + hstep, voffB); PG8_STAGE(PG8_SA(0, 1), cA + hstep, voffA);
        if (wr == 1) PG8_BAR;
        PG8_WAIT_V(4); PG8_BAR;
        PG8_STAGE(PG8_SB(1, 0), cB + kstep, voffB); PG8_STAGE(PG8_SA(1, 0), cA + kstep, voffA); PG8_STAGE(PG8_SB(1, 1), cB + hstep + kstep, voffB);
        PG8_WAIT_V(6); PG8_BAR;
    }
    for (;;) {
        const bool has_next = S.next(ui + 1, nxt);
        const char* nA = has_next ? (const char*)g.A + (size_t)nxt.pm * tstep : cA; const char* nB = has_next ? (const char*)g.Bt + (size_t)nxt.pn * tstep : cB;
        asm volatile(".p2align 6\n\ts_nop 0\n\ts_nop 0\n\ts_nop 0\n\ts_nop 0\n\ts_nop 0\n\ts_nop 0\n\ts_nop 0\n\ts_nop 0" ::: );
        for (int t = 0; t < nt; t += 2) {
            const bool last = (t == nt - 2);
            const char* a1 = cA + (size_t)(t + 1) * kstep;
            const char* a2 = last ? nA : cA + (size_t)(t + 2) * kstep; const char* b2 = last ? nB : cB + (size_t)(t + 2) * kstep;
            const char* a3 = a2 + kstep; const char* b3 = b2 + kstep;
            if (last && has_next) S.a_ready(nxt);
            if constexpr (SP2) {
            PG8_LDB(B0, 0, 0); PG8_LDB(B1, 0, 1); PG8_SCHED; PG8_LDA(At, 0, 0); PG8_STAGE(PG8_SA(1, 1), a1 + hstep, voffA);
            PG8_WAIT_V(8); PG8_WAIT_L(0); PG8_BAR; PG8_MMA(0, 0, At, B0); PG8_MMA(0, 1, At, B1); PG8_BAR; PG8_SCHED;
            PG8_LDA(At, 0, 1); PG8_STAGE(PG8_SB(0, 0), b2, voffB); PG8_STAGE(PG8_SB(0, 1), b2 + hstep, voffB); PG8_STAGE(PG8_SA(0, 0), a2, voffA);
            PG8_WAIT_V(8); PG8_WAIT_L(0); PG8_BAR; PG8_MMA(1, 0, At, B0); PG8_MMA(1, 1, At, B1); PG8_BAR; PG8_SCHED;
            PG8_LDB(B0, 1, 0); PG8_LDB(B1, 1, 1); PG8_SCHED; PG8_LDA(At, 1, 0); PG8_STAGE(PG8_SA(0, 1), a2 + hstep, voffA);
            PG8_WAIT_V(8); PG8_WAIT_L(0); PG8_BAR; PG8_MMA(0, 0, At, B0); PG8_MMA(0, 1, At, B1); PG8_BAR; PG8_SCHED;
            PG8_LDA(At, 1, 1); PG8_STAGE(PG8_SB(1, 0), b3, voffB); PG8_STAGE(PG8_SB(1, 1), b3 + hstep, voffB); PG8_STAGE(PG8_SA(1, 0), a3, voffA);
            PG8_WAIT_V(8); PG8_WAIT_L(0); PG8_BAR; PG8_MMA(1, 0, At, B0); PG8_MMA(1, 1, At, B1); PG8_BAR; PG8_SCHED;
            } else {
            PG8_LDB(B0, 0, 0); PG8_SCHED; PG8_LDA(At, 0, 0); PG8_STAGE(PG8_SA(1, 1), a1 + hstep, voffA);
            PG8_WAIT_L(8); PG8_BAR; PG8_WAIT_L(0); PG8_MMA(0, 0, At, B0); PG8_BAR; PG8_SCHED;
            PG8_LDB(B1, 0, 1); PG8_STAGE(PG8_SB(0, 0), b2, voffB);
            PG8_BAR; PG8_WAIT_L(0); PG8_MMA(0, 1, At, B1); PG8_BAR;
            PG8_LDA(At, 0, 1); PG8_STAGE(PG8_SA(0, 0), a2, voffA);
            PG8_BAR; PG8_WAIT_L(0); PG8_MMA(1, 0, At, B0); PG8_BAR; PG8_SCHED;
            PG8_STAGE(PG8_SB(0, 1), b2 + hstep, voffB);
            PG8_WAIT_V(6); PG8_BAR; PG8_MMA(1, 1, At, B1); PG8_BAR;
            PG8_LDB(B0, 1, 0); PG8_SCHED; PG8_LDA(At, 1, 0); PG8_STAGE(PG8_SA(0, 1), a2 + hstep, voffA);
            PG8_WAIT_L(8); PG8_BAR; PG8_WAIT_L(0); PG8_MMA(0, 0, At, B0); PG8_BAR; PG8_SCHED;
            PG8_LDB(B1, 1, 1); PG8_STAGE(PG8_SB(1, 0), b3, voffB);
            PG8_BAR; PG8_WAIT_L(0); PG8_MMA(0, 1, At, B1); PG8_BAR;
            PG8_LDA(At, 1, 1); PG8_STAGE(PG8_SA(1, 0), a3, voffA);
            PG8_BAR; PG8_WAIT_L(0); PG8_MMA(1, 0, At, B0); PG8_BAR; PG8_SCHED;
            PG8_STAGE(PG8_SB(1, 1), b3 + hstep, voffB);
            PG8_WAIT_V(6); PG8_BAR; PG8_MMA(1, 1, At, B1); PG8_BAR;
            }
        }
        if constexpr (ALIGN_EPI) { if (wr == 0) PG8_BAR; }
        if constexpr (!Epi::AFTER_DRAIN) { E(acc, cur, wr, wc, fr, fq); S.done(cur); }
        if (!has_next) break;
#pragma unroll
        for (int a = 0; a < 2; ++a)
#pragma unroll
            for (int b = 0; b < 2; ++b)
#pragma unroll
                for (int m = 0; m < 4; ++m)
#pragma unroll
                    for (int n = 0; n < 2; ++n) acc[a][b][m][n] = (f32x4){0.f, 0.f, 0.f, 0.f};
        cur = nxt; cA = nA; cB = nB; ++ui;
        if constexpr (ALIGN_EPI) { if (wr == 1) PG8_BAR; }
    }
    PG8_WAIT_V(0);
    if constexpr (!ALIGN_EPI) { if (wr == 0) PG8_BAR; }
    PG8_BAR;
#undef PG8_SA
#undef PG8_SB
#undef PG8_STAGE
#undef PG8_LDA
#undef PG8_LDB
#undef PG8_MMA
#undef PG8_WAIT_V
#undef PG8_WAIT_L
#undef PG8_BAR
#undef PG8_SCHED
}
}

typedef unsigned short bf16_t;
typedef float f32x4 __attribute__((ext_vector_type(4)));
typedef unsigned u32x4 __attribute__((ext_vector_type(4)));
typedef unsigned u32x2 __attribute__((ext_vector_type(2)));
typedef short bf16x8 __attribute__((ext_vector_type(8)));
#define LAS __attribute__((address_space(3)))

constexpr int NWAVES = 8;
constexpr int SEQ = 4096, NB = 8, TOK = NB * SEQ, DM = 1024, FF = 2816, NP = 1792;
constexpr int OFF_GATE = 256, OFF_Q = 512, OFF_K = 1024, OFF_V = 1152, OFF_GLU = 1280;
constexpr float NORM_EPS = 1e-6f, LN_EPS = 1e-5f;

constexpr size_t MiB = 1u << 20;
constexpr size_t W_GU = (size_t)2 * FF * DM * 2, W_DOWN = (size_t)DM * FF * 2, W_IN = (size_t)NP * DM * 2, W_OUT = (size_t)DM * DM * 2;
constexpr size_t WO_GU1 = 0, WO_DOWN1 = WO_GU1 + W_GU, WO_IN = WO_DOWN1 + W_DOWN, WO_OUT = WO_IN + W_IN, WO_GU2 = WO_OUT + W_OUT, WO_DOWN2 = WO_GU2 + W_GU, W_LAYER = WO_DOWN2 + W_DOWN;
constexpr size_t WS_W = 1 * MiB;
constexpr size_t WS_H = 80 * MiB;
constexpr size_t WS_Y = 144 * MiB;
constexpr size_t WS_ACT = 208 * MiB;
constexpr size_t WS_PROJ = 208 * MiB;
constexpr size_t WS_YMIX = 320 * MiB;
constexpr size_t WS_PH = 384 * MiB;
constexpr size_t WS_AGG = 416 * MiB;
constexpr size_t WS_RS = 417 * MiB;
constexpr size_t WS_SLOTS = 418 * MiB;
constexpr size_t SLOT_BANK = (size_t)TOK * 4 * 8;
constexpr size_t WS_END = 424 * MiB;
static_assert(WS_W + 2 * W_LAYER <= WS_H, "weights fit");

constexpr size_t CTL_CNT = 65536;
constexpr size_t CTL_CNT_BYTES = 6 * 32768;
constexpr size_t CTL_SLOTS = 524288;
constexpr int XL_OFF = 131072 + 1024;
constexpr int RSTAB_OFF = 131072 + 7168;
constexpr int LDS_BYTES = 147456;

__device__ __forceinline__ float bflo(unsigned u) { return __uint_as_float(u << 16); }
__device__ __forceinline__ float bfhi(unsigned u) { return __uint_as_float(u & 0xffff0000u); }
__device__ __forceinline__ float bf1(bf16_t u) { return __uint_as_float((unsigned)u << 16); }
__device__ __forceinline__ unsigned pk2(float lo, float hi) { return pg8::cvt_pk_bf16(lo, hi); }
#define DPP_ADD(v, ctrl) ((v) + __builtin_bit_cast(float, __builtin_amdgcn_update_dpp(0, __builtin_bit_cast(int, (v)), (ctrl), 0xF, 0xF, false)))
__device__ __forceinline__ float wave_sum(float v) {
    v = DPP_ADD(v, 0xB1);
    v = DPP_ADD(v, 0x4E);
    v = DPP_ADD(v, 0x141);
    v = DPP_ADD(v, 0x140);
    return (__builtin_bit_cast(float, __builtin_amdgcn_readlane(__builtin_bit_cast(int, v), 0)) + __builtin_bit_cast(float, __builtin_amdgcn_readlane(__builtin_bit_cast(int, v), 16))) +
           (__builtin_bit_cast(float, __builtin_amdgcn_readlane(__builtin_bit_cast(int, v), 32)) + __builtin_bit_cast(float, __builtin_amdgcn_readlane(__builtin_bit_cast(int, v), 48)));
}
__device__ __forceinline__ float sigmoidf_(float x) { return __builtin_amdgcn_rcpf(1.f + __expf(-x)); }
__device__ __forceinline__ float dot4(f32x4 a) { return (a.x * a.x + a.y * a.y) + (a.z * a.z + a.w * a.w); }
__device__ __forceinline__ float gelu_tanh(float x) {
    const float z = 0.7978845608028654f * (x + 0.044715f * x * x * x);
    const float t = 1.f - 2.f * __builtin_amdgcn_rcpf(__expf(2.f * z) + 1.f);
    return 0.5f * x * (1.f + t);
}

__device__ __forceinline__ void transpose_item(const float* W, int K, int N, bf16_t* WT, bool gu, const float* gain, int item, int lane) {
    const int nblk = N / 64, kb = item / nblk, nb = item % nblk, k0 = 64 * kb, n = 64 * nb + lane;
    float v[64];
    const float* wp = W + (size_t)k0 * N + n;
#pragma unroll
    for (int i = 0; i < 64; ++i) v[i] = __builtin_nontemporal_load(wp + (size_t)i * N);
    if (gain) {
#pragma unroll
        for (int i = 0; i < 64; ++i) v[i] *= gain[k0 + i]; }
    int row = n;
    if (gu) { const int bj = n / FF, r = n % FF, pn = r / 128, j = r % 128; row = 256 * pn + 128 * bj + j; }
    bf16_t* dst = WT + (size_t)row * K + k0;
#pragma unroll
    for (int c = 0; c < 8; ++c) { u32x4 o; o.x = pk2(v[8 * c], v[8 * c + 1]); o.y = pk2(v[8 * c + 2], v[8 * c + 3]); o.z = pk2(v[8 * c + 4], v[8 * c + 5]); o.w = pk2(v[8 * c + 6], v[8 * c + 7]);
        *(u32x4*)(dst + 8 * c) = o; }
}

template <int MODE>
__device__ __forceinline__ void norm_phase(int gw, int NGW, int lane, const float* xin, float* xout, bf16_t* XB, const bf16_t* Y, const float* post_g, float scale, float* rs) {
    constexpr bool XF32 = (MODE == 0 || MODE == 3), HASY = (MODE != 0);
    f32x4 qg[4];
#pragma unroll
    for (int j = 0; j < 4; ++j) qg[j] = HASY ? ((const f32x4*)post_g)[lane + 64 * j] : (f32x4){0.f, 0.f, 0.f, 0.f};
    f32x4 v[4]; u32x2 xw[4], yw[4];
    if (gw < TOK) {
        if (XF32) { const f32x4* xr = (const f32x4*)(xin + (size_t)gw * DM) + lane;
#pragma unroll
            for (int j = 0; j < 4; ++j) v[j] = xr[64 * j]; }
        else { const u32x2* xr = (const u32x2*)(XB + (size_t)gw * DM) + lane;
#pragma unroll
            for (int j = 0; j < 4; ++j) xw[j] = xr[64 * j]; }
        if (HASY) { const u32x2* yr = (const u32x2*)(Y + (size_t)gw * DM) + lane;
#pragma unroll
            for (int j = 0; j < 4; ++j) yw[j] = yr[64 * j]; }
    }
    for (int m = gw; m < TOK; m += NGW) {
        f32x4 vn[4]; u32x2 xwn[4], ywn[4];
        const int mn = (m + NGW < TOK) ? m + NGW : m;
        {
            if (XF32) { const f32x4* xr = (const f32x4*)(xin + (size_t)mn * DM) + lane;
#pragma unroll
                for (int j = 0; j < 4; ++j) vn[j] = xr[64 * j]; }
            else { const u32x2* xr = (const u32x2*)(XB + (size_t)mn * DM) + lane;
#pragma unroll
                for (int j = 0; j < 4; ++j) xwn[j] = xr[64 * j]; }
            if (HASY) { const u32x2* yr = (const u32x2*)(Y + (size_t)mn * DM) + lane;
#pragma unroll
                for (int j = 0; j < 4; ++j) ywn[j] = yr[64 * j]; }
        }
        if (!XF32) {
#pragma unroll
            for (int j = 0; j < 4; ++j) v[j] = (f32x4){bflo(xw[j].x), bfhi(xw[j].x), bflo(xw[j].y), bfhi(xw[j].y)};
        }
        if (HASY) {
            f32x4 y[4]; float ss = 0.f;
#pragma unroll
            for (int j = 0; j < 4; ++j) { const u32x2 w = yw[j]; y[j] = (f32x4){bflo(w.x), bfhi(w.x), bflo(w.y), bfhi(w.y)}; ss += dot4(y[j]); }
            ss = wave_sum(ss);
            const float r = rsqrtf(ss * (1.f / DM) + NORM_EPS) * scale;
#pragma unroll
            for (int j = 0; j < 4; ++j) v[j] = v[j] + y[j] * r * qg[j];
        }
        if (MODE == 2) {
            f32x4* xo = (f32x4*)(xout + (size_t)m * DM) + lane;
#pragma unroll
            for (int j = 0; j < 4; ++j) xo[64 * j] = v[j];
        } else {
            float ss = 0.f;
#pragma unroll
            for (int j = 0; j < 4; ++j) ss += dot4(v[j]);
            ss = wave_sum(ss);
            if (lane == 0) *(f32x4*)(rs + (size_t)m * 4) = (f32x4){ss, 0.f, 0.f, 0.f};
            u32x2* ho = (u32x2*)(XB + (size_t)m * DM) + lane;
#pragma unroll
            for (int j = 0; j < 4; ++j) { u32x2 w; w.x = pk2(v[j].x, v[j].y); w.y = pk2(v[j].z, v[j].w); ho[64 * j] = w; }
        }
#pragma unroll
        for (int j = 0; j < 4; ++j) { if (XF32) v[j] = vn[j]; else xw[j] = xwn[j]; if (HASY) yw[j] = ywn[j]; }
    }
}

typedef __bf16 bf16x2_t __attribute__((ext_vector_type(2)));
__device__ __forceinline__ float dot2bf(unsigned a, unsigned b, float c) { return __builtin_amdgcn_fdot2_f32_bf16(__builtin_bit_cast(bf16x2_t, a), __builtin_bit_cast(bf16x2_t, b), c, false); }
__device__ __forceinline__ void lru_local_item(int item, int lane, unsigned char* wl  , const bf16_t* proj,
                                               const float* cw, const float* cbias, const float* wa, const float* ba, const float* wx, const float* bx, const float* lam,
                                               unsigned* PH, float* AGG) {
    bf16_t* xc = (bf16_t*)wl;
    float* ab = (float*)(wl + 9216);
    const int b = item >> 8, c = (item >> 2) & 63, hb = item & 3;
    const int ch = hb * 64 + lane;
    const int q16 = lane & 15, g = lane >> 4;
    const size_t tok0 = (size_t)b * SEQ + (size_t)c * 64;
    const float w0 = cw[ch], w1 = cw[256 + ch], w2 = cw[512 + ch], w3 = cw[768 + ch], cb = cbias[ch];
    const bf16_t* xp = proj + tok0 * NP + ch;
    float xm3 = 0.f, xm2 = 0.f, xm1 = 0.f;
    if (c > 0) { xm3 = bf1(xp[-3 * NP]); xm2 = bf1(xp[-2 * NP]); xm1 = bf1(xp[-1 * NP]); }
    bf16_t xin[64];
#pragma unroll
    for (int t = 0; t < 64; ++t) xin[t] = xp[(size_t)t * NP];
    bf16x8 Wa[4][2], Wx[4][2];
    {
        const float* wap = wa + hb * 4096 + (8 * g) * 64 + q16; const float* wxp = wx + hb * 4096 + (8 * g) * 64 + q16;
#pragma unroll
        for (int ct = 0; ct < 4; ++ct)
#pragma unroll
            for (int ks = 0; ks < 2; ++ks) {
                const float* pa = wap + ks * 32 * 64 + ct * 16; const float* px = wxp + ks * 32 * 64 + ct * 16;
                u32x4 va, vx;
                va.x = pk2(pa[0], pa[64]); va.y = pk2(pa[128], pa[192]); va.z = pk2(pa[256], pa[320]); va.w = pk2(pa[384], pa[448]);
                vx.x = pk2(px[0], px[64]); vx.y = pk2(px[128], px[192]); vx.z = pk2(px[256], px[320]); vx.w = pk2(px[384], px[448]);
                Wa[ct][ks] = __builtin_bit_cast(bf16x8, va); Wx[ct][ks] = __builtin_bit_cast(bf16x8, vx);
            }
    }
    float bav[4], bxv[4], sp8[4];
#pragma unroll
    for (int ct = 0; ct < 4; ++ct) { const int cc = hb * 64 + ct * 16 + q16; bav[ct] = ba[cc]; bxv[ct] = bx[cc]; sp8[ct] = -8.f * log1pf(__expf(-lam[cc])); }
#pragma unroll
    for (int t = 0; t < 64; ++t) {
        const float x0 = bf1(xin[t]);
        const float v = cb + w0 * xm3 + w1 * xm2 + w2 * xm1 + w3 * x0;
        xc[t * 72 + lane] = (bf16_t)(pk2(v, v) & 0xffffu);
        xm3 = xm2; xm2 = xm1; xm1 = x0;
    }
    float h = 0.f, P = 1.f;
    unsigned* php = PH + tok0 * 256 + ch;
#pragma unroll 1
    for (int T = 0; T < 4; ++T) {
        const bf16_t* arow = xc + (T * 16 + q16) * 72 + 8 * g;
        const bf16x8 A0 = *(const bf16x8*)arow, A1 = *(const bf16x8*)(arow + 32);
#pragma unroll
        for (int ct = 0; ct < 4; ++ct) {
            f32x4 r = (f32x4){0.f, 0.f, 0.f, 0.f}, ii = (f32x4){0.f, 0.f, 0.f, 0.f};
            r = __builtin_amdgcn_mfma_f32_16x16x32_bf16(A0, Wa[ct][0], r, 0, 0, 0); r = __builtin_amdgcn_mfma_f32_16x16x32_bf16(A1, Wa[ct][1], r, 0, 0, 0);
            ii = __builtin_amdgcn_mfma_f32_16x16x32_bf16(A0, Wx[ct][0], ii, 0, 0, 0); ii = __builtin_amdgcn_mfma_f32_16x16x32_bf16(A1, Wx[ct][1], ii, 0, 0, 0);
#pragma unroll
            for (int e = 0; e < 4; ++e) {
                const int tl = 4 * g + e;
                const float xcv = bf1(xc[(T * 16 + tl) * 72 + ct * 16 + q16]);
                const float rr = sigmoidf_(r[e] + bav[ct]), ig = sigmoidf_(ii[e] + bxv[ct]);
                const float av = __expf(sp8[ct] * rr);
                const float bv = sqrtf(fmaxf(1.f - av * av, 0.f)) * ig * xcv;
                *(float2*)(ab + (tl * 64 + ct * 16 + q16) * 2) = make_float2(av, bv);
            }
        }
#pragma unroll 4
        for (int t = 0; t < 16; ++t) {
            const float2 v = *(const float2*)(ab + (t * 64 + lane) * 2);
            h = v.x * h + v.y; P *= v.x;
            php[(size_t)(T * 16 + t) * 256] = pk2(P, h);
        }
    }
    float* ag = AGG + ((size_t)(b * 64 + c) * 256 + ch) * 2;
    ag[0] = P; ag[1] = h;
}

__device__ __forceinline__ void attn_item(int item, unsigned char* smem, int tid, int lane, int wave, const bf16_t* proj, const float* sinks, bf16_t* ymix) {
    const int b = item >> 6, kvh = (item >> 5) & 1, qb = item & 31;
    bf16_t* Ks = (bf16_t*)smem;
    bf16_t* Vt = (bf16_t*)(smem + 36864);
    const long tokb = (long)b * SEQ + (long)(qb - 1) * 128;
#pragma unroll
    for (int i = 0; i < 4; ++i) {
        const int p = tid + 512 * i; const int row = p >> 3, c8 = p & 7;
        u32x4 kv = (u32x4){0u, 0u, 0u, 0u}, vv = (u32x4){0u, 0u, 0u, 0u};
        if (qb > 0 || row >= 128) {
            const bf16_t* src = proj + (tokb + row) * NP;
            kv = *(const u32x4*)(src + OFF_K + kvh * 64 + c8 * 8);
            vv = *(const u32x4*)(src + OFF_V + kvh * 64 + c8 * 8);
        }
        *(u32x4*)(Ks + row * 72 + c8 * 8) = kv;
        bf16_t* vd = Vt + (c8 * 8) * 264 + row;
        vd[0 * 264] = (bf16_t)(vv.x & 0xffffu); vd[1 * 264] = (bf16_t)(vv.x >> 16);
        vd[2 * 264] = (bf16_t)(vv.y & 0xffffu); vd[3 * 264] = (bf16_t)(vv.y >> 16);
        vd[4 * 264] = (bf16_t)(vv.z & 0xffffu); vd[5 * 264] = (bf16_t)(vv.z >> 16);
        vd[6 * 264] = (bf16_t)(vv.w & 0xffffu); vd[7 * 264] = (bf16_t)(vv.w >> 16);
    }
    __syncthreads();
    const int hq = kvh * 4 + (wave & 3), half = wave >> 2, kstart = half * 64;
    const int q16 = lane & 15, g = lane >> 4;
    const float sink = sinks[hq];
    bf16x8 qn0, qn1;
    { const bf16_t* qp = proj + ((size_t)b * SEQ + (size_t)qb * 128 + half * 64 + q16) * NP + OFF_Q + hq * 64 + 8 * g; qn0 = *(const bf16x8*)qp; qn1 = *(const bf16x8*)(qp + 32); }
#pragma unroll 1
    for (int qt = 0; qt < 4; ++qt) {
        const int qloc = half * 64 + qt * 16 + q16;
        const int qband = 128 + qloc;
        const size_t qtok = (size_t)b * SEQ + (size_t)qb * 128 + qloc;
        const bf16x8 qf0 = qn0, qf1 = qn1;
        { const int qtn = qt < 3 ? qt + 1 : qt;
          const bf16_t* qp = proj + ((size_t)b * SEQ + (size_t)qb * 128 + half * 64 + qtn * 16 + q16) * NP + OFF_Q + hq * 64 + 8 * g; qn0 = *(const bf16x8*)qp; qn1 = *(const bf16x8*)(qp + 32); }
        f32x4 s[9];
        const int kt0 = kstart + qt * 16;
#pragma unroll
        for (int j = 0; j < 9; ++j) {
            const bf16_t* kp = Ks + (kt0 + j * 16 + q16) * 72 + 8 * g;
            const bf16x8 k0 = *(const bf16x8*)kp, k1 = *(const bf16x8*)(kp + 32);
            f32x4 a = (f32x4){0.f, 0.f, 0.f, 0.f};
            a = __builtin_amdgcn_mfma_f32_16x16x32_bf16(k0, qf0, a, 0, 0, 0);
            a = __builtin_amdgcn_mfma_f32_16x16x32_bf16(k1, qf1, a, 0, 0, 0);
            s[j] = a;
        }
        float m = -1e30f;
#pragma unroll
        for (int j = 0; j < 9; ++j) {
            const bool dead = (qb == 0) && (kt0 + j * 16 < 128);
#pragma unroll
            for (int e = 0; e < 4; ++e) {
                float v = dead ? -1e30f : s[j][e] * 0.125f;
                if (j == 0) v = (4 * g + e > q16) ? v : -1e30f;
                if (j == 8) v = (4 * g + e <= q16) ? v : -1e30f;
                s[j][e] = v; m = fmaxf(m, v);
            }
        }
        m = xmax16(m); m = xmax32(m); m = fmaxf(m, sink);
        float sum = 0.f;
#pragma unroll
        for (int j = 0; j < 9; ++j)
#pragma unroll
            for (int e = 0; e < 4; ++e) { const float p = __expf(s[j][e] - m); s[j][e] = p; sum += p; }
        sum = xsum16(sum); sum = xsum32(sum);
        const float inv = 1.f / (sum + __expf(sink - m));
        bf16x8 pf[5];
#pragma unroll
        for (int kk = 0; kk < 4; ++kk) {
            u32x4 w; w.x = pk2(s[2 * kk][0], s[2 * kk][1]); w.y = pk2(s[2 * kk][2], s[2 * kk][3]); w.z = pk2(s[2 * kk + 1][0], s[2 * kk + 1][1]); w.w = pk2(s[2 * kk + 1][2], s[2 * kk + 1][3]);
            pf[kk] = __builtin_bit_cast(bf16x8, w);
        }
        { u32x4 w; w.x = pk2(s[8][0], s[8][1]); w.y = pk2(s[8][2], s[8][3]); w.z = 0u; w.w = 0u; pf[4] = __builtin_bit_cast(bf16x8, w); }
        bf16_t* op = ymix + qtok * DM + 256 + hq * 64 + 4 * g;
#pragma unroll
        for (int dt = 0; dt < 4; ++dt) {
            f32x4 o = (f32x4){0.f, 0.f, 0.f, 0.f};
#pragma unroll
            for (int kk = 0; kk < 5; ++kk) {
                const bf16_t* vp = Vt + (dt * 16 + q16) * 264 + kt0 + kk * 32 + 4 * g;
                const u32x2 lo = *(const u32x2*)vp, hi = (kk < 4) ? *(const u32x2*)(vp + 16) : lo;
                const u32x4 vw = (u32x4){lo.x, lo.y, hi.x, hi.y};
                o = __builtin_amdgcn_mfma_f32_16x16x32_bf16(__builtin_bit_cast(bf16x8, vw), pf[kk], o, 0, 0, 0);
            }
            u32x2 w; w.x = pk2(o[0] * inv, o[1] * inv); w.y = pk2(o[2] * inv, o[3] * inv);
            *(u32x2*)(op + dt * 16) = w;
        }
    }
    __syncthreads();
}

__device__ __forceinline__ void conf_phase(int bx, int G, unsigned char* smem, int tid, int lane, int wave, const bf16_t* proj,
                                           const float* cw, const float* cbias, const float* lng, const float* lnb, const float* gg, bf16_t* ymix) {
    constexpr int NITEM = NB * 128;
    float* st = (float*)smem;
    float* ot = (float*)(smem + 63488);
    const int ch = tid & 255, th = tid >> 8;
    float w[31];
#pragma unroll
    for (int k = 0; k < 31; ++k) w[k] = cw[k * 256 + ch];
    const float bias = cbias[ch];
    const f32x4 lg = ((const f32x4*)lng)[lane], lb = ((const f32x4*)lnb)[lane], ggv = ((const f32x4*)gg)[lane];
    u32x4 rav[4], rgv[4];
#define CONF_FETCH(item) do { const int b_ = (item) >> 7, t0_ = ((item) & 127) * 32; _Pragma("unroll") for (int i = 0; i < 4; ++i) { const int p = tid + 512 * i; const int row = p >> 5, c8 = p & 31; const int t = t0_ - 30 + row; \
        rav[i] = (u32x4){0u, 0u, 0u, 0u}; rgv[i] = (u32x4){0u, 0u, 0u, 0u}; \
        if (p < 62 * 32 && t >= 0) { const bf16_t* src = proj + ((size_t)b_ * SEQ + t) * NP + OFF_GLU + c8 * 8; rav[i] = *(const u32x4*)src; rgv[i] = *(const u32x4*)(src + 256); } } } while (0)
    if (bx < NITEM) CONF_FETCH(bx);
    for (int item = bx; item < NITEM; item += G) {
        const int b = item >> 7, t0 = (item & 127) * 32;
#pragma unroll
        for (int i = 0; i < 4; ++i) {
            const int p = tid + 512 * i; const int row = p >> 5, c8 = p & 31;
            if (p < 62 * 32) {
                const u32x4 av = rav[i], gv = rgv[i];
                f32x4 y0, y1;
                y0.x = bflo(av.x) * sigmoidf_(bflo(gv.x)); y0.y = bfhi(av.x) * sigmoidf_(bfhi(gv.x));
                y0.z = bflo(av.y) * sigmoidf_(bflo(gv.y)); y0.w = bfhi(av.y) * sigmoidf_(bfhi(gv.y));
                y1.x = bflo(av.z) * sigmoidf_(bflo(gv.z)); y1.y = bfhi(av.z) * sigmoidf_(bfhi(gv.z));
                y1.z = bflo(av.w) * sigmoidf_(bflo(gv.w)); y1.w = bfhi(av.w) * sigmoidf_(bfhi(gv.w));
                *(f32x4*)(st + row * 256 + c8 * 8) = y0; *(f32x4*)(st + row * 256 + c8 * 8 + 4) = y1;
            }
        }
        __syncthreads();
        if (item + G < NITEM) CONF_FETCH(item + G);
#pragma unroll 1
        for (int gi = 0; gi < 2; ++gi) {
            const int tau0 = th * 16 + gi * 8;
            float in[38];
#pragma unroll
            for (int i = 0; i < 38; ++i) in[i] = st[(tau0 + i) * 256 + ch];
#pragma unroll
            for (int o = 0; o < 8; ++o) { float acc = bias;
#pragma unroll
                for (int k = 0; k < 31; ++k) acc += w[k] * in[o + k];
                ot[(tau0 + o) * 256 + ch] = acc; }
        }
        __syncthreads();
#pragma unroll 2
        for (int i = 0; i < 4; ++i) {
            const int tau = wave * 4 + i;
            const f32x4 v = *(const f32x4*)(ot + tau * 256 + 4 * lane);
            const float mu = wave_sum((v.x + v.y) + (v.z + v.w)) * (1.f / 256.f);
            const f32x4 d = v - mu;
            const float rstd = rsqrtf(wave_sum(dot4(d)) * (1.f / 256.f) + LN_EPS);
            f32x4 y = d * rstd * lg + lb;
            y.x *= sigmoidf_(y.x); y.y *= sigmoidf_(y.y); y.z *= sigmoidf_(y.z); y.w *= sigmoidf_(y.w);
            const float r = rsqrtf(wave_sum(dot4(y)) * (1.f / 256.f) + NORM_EPS);
            const f32x4 o = y * r * ggv;
            u32x2 wv; wv.x = pk2(o.x, o.y); wv.y = pk2(o.z, o.w);
            *(u32x2*)(ymix + ((size_t)b * SEQ + t0 + tau) * DM + 768 + 4 * lane) = wv;
        }
    }
#undef CONF_FETCH
    __syncthreads();
}

__device__ __forceinline__ void mix2_item(int item, unsigned char* smem, int tid, int lane, int wave, const bf16_t* proj, const unsigned* PH, const float* AGG, const float* gg, bf16_t* ymix) {
    const int b = item >> 6, c = item & 63;
    float* segA = (float*)smem;
    float* segH = (float*)(smem + 8192);
    {
        const int seg = (c + 7) >> 3; const int c0 = wave * seg; const int c1 = (c0 + seg < c) ? c0 + seg : c;
        const float* ag = AGG + ((size_t)(b * 64) * 256 + 4 * lane) * 2;
        f32x4 lo[8], hi[8];
#pragma unroll
        for (int k = 0; k < 8; ++k) { const int cc = c0 + k;
            if (cc < c1) { lo[k] = *(const f32x4*)(ag + (size_t)cc * 512); hi[k] = *(const f32x4*)(ag + (size_t)cc * 512 + 4); }
            else { lo[k] = (f32x4){1.f, 0.f, 1.f, 0.f}; hi[k] = (f32x4){1.f, 0.f, 1.f, 0.f}; } }
        f32x4 A = (f32x4){1.f, 1.f, 1.f, 1.f}, Hh = (f32x4){0.f, 0.f, 0.f, 0.f};
#pragma unroll
        for (int k = 0; k < 8; ++k) {
            Hh.x = lo[k].x * Hh.x + lo[k].y; A.x *= lo[k].x; Hh.y = lo[k].z * Hh.y + lo[k].w; A.y *= lo[k].z;
            Hh.z = hi[k].x * Hh.z + hi[k].y; A.z *= hi[k].x; Hh.w = hi[k].z * Hh.w + hi[k].w; A.w *= hi[k].z; }
        *(f32x4*)(segA + wave * 256 + 4 * lane) = A; *(f32x4*)(segH + wave * 256 + 4 * lane) = Hh;
    }
    __syncthreads();
    f32x4 cr4 = (f32x4){0.f, 0.f, 0.f, 0.f};
#pragma unroll
    for (int sgi = 0; sgi < 8; ++sgi) { const f32x4 a = *(const f32x4*)(segA + sgi * 256 + 4 * lane), hh = *(const f32x4*)(segH + sgi * 256 + 4 * lane); cr4 = a * cr4 + hh; }
    const f32x4 ga = ((const f32x4*)gg)[lane];
    const f32x4 gb0 = ((const f32x4*)(gg + 256))[2 * lane], gb1 = ((const f32x4*)(gg + 256))[2 * lane + 1];
    const size_t tokb = (size_t)b * SEQ + (size_t)c * 64 + wave * 8;
    u32x4 phv[8], ovv[8]; u32x2 gtv[8];
#pragma unroll
    for (int i = 0; i < 8; ++i) {
        phv[i] = *(const u32x4*)(PH + (tokb + i) * 256 + 4 * lane);
        gtv[i] = *(const u32x2*)(proj + (tokb + i) * NP + OFF_GATE + 4 * lane);
        ovv[i] = *(const u32x4*)(ymix + (tokb + i) * DM + 256 + 8 * lane);
    }
#pragma unroll
    for (int i = 0; i < 8; ++i) {
        const u32x4 ph = phv[i]; const u32x2 gt = gtv[i]; const u32x4 ov = ovv[i];
        f32x4 ya;
        ya.x = gelu_tanh(bflo(gt.x)) * (bfhi(ph.x) + bflo(ph.x) * cr4.x);
        ya.y = gelu_tanh(bfhi(gt.x)) * (bfhi(ph.y) + bflo(ph.y) * cr4.y);
        ya.z = gelu_tanh(bflo(gt.y)) * (bfhi(ph.z) + bflo(ph.z) * cr4.z);
        ya.w = gelu_tanh(bfhi(gt.y)) * (bfhi(ph.w) + bflo(ph.w) * cr4.w);
        const float ra = rsqrtf(wave_sum(dot4(ya)) * (1.f / 256.f) + NORM_EPS);
        const f32x4 oa = ya * ra * ga;
        u32x2 wv; wv.x = pk2(oa.x, oa.y); wv.y = pk2(oa.z, oa.w);
        bf16_t* yrow = ymix + (tokb + i) * DM;
        *(u32x2*)(yrow + 4 * lane) = wv;
        f32x4 b0 = (f32x4){bflo(ov.x), bfhi(ov.x), bflo(ov.y), bfhi(ov.y)}, b1 = (f32x4){bflo(ov.z), bfhi(ov.z), bflo(ov.w), bfhi(ov.w)};
        const float rb = rsqrtf(wave_sum(dot4(b0) + dot4(b1)) * (1.f / 512.f) + NORM_EPS);
        b0 = b0 * rb * gb0; b1 = b1 * rb * gb1;
        u32x4 ow; ow.x = pk2(b0.x, b0.y); ow.y = pk2(b0.z, b0.w); ow.z = pk2(b1.x, b1.y); ow.w = pk2(b1.z, b1.w);
        *(u32x4*)(yrow + 256 + 8 * lane) = ow;
    }
    __syncthreads();
}


#define XB_TMO      128
#define XB_XCNT(j)  (256  + 64 * (j))
#define XB_XSUB(j)  (1280 + 64 * (j))
#define XB_XGEN(j)  (2304 + 64 * (j))
#define XB_TOP      3328
#define XB_TOPGEN   3392
#define XCD_BAR_WORDS 3456
#define XB_SPIN_CAP (1u << 18)
__device__ __forceinline__ unsigned xb_ld(unsigned* p)              { return __hip_atomic_load(p, __ATOMIC_RELAXED, __HIP_MEMORY_SCOPE_AGENT); }
__device__ __forceinline__ unsigned xb_add(unsigned* p, unsigned v) { return __hip_atomic_fetch_add(p, v, __ATOMIC_RELAXED, __HIP_MEMORY_SCOPE_AGENT); }
__device__ __forceinline__ unsigned xb_xcc_id() { return (unsigned)__builtin_amdgcn_s_getreg((3 << 11) | 20) & 0xFu; }
#define XB_SPIN(cond, bar) do { unsigned _sp = 0; while (cond) { __builtin_amdgcn_s_sleep(1); \
    if ((++_sp & 255u) == 0u) { if (xb_ld(&(bar)[XB_TMO])) break; if (_sp > XB_SPIN_CAP) { atomicAdd(&(bar)[XB_TMO], 1u); break; } } } } while (0)
struct XcdBarrier { unsigned* bar; unsigned x; volatile LAS unsigned* st; };
__device__ __forceinline__ void xcd_barrier_complete(unsigned* bar, unsigned x, unsigned& nloc, unsigned& nx) {
    const unsigned G = gridDim.x * gridDim.y * gridDim.z;
    unsigned sum, cnt, mine, sp = 0u;
    for (;;) {
        sum = 0u; cnt = 0u; mine = 0u;
#pragma unroll
        for (unsigned j = 0; j < 16; ++j) { const unsigned c = xb_ld(&bar[XB_XCNT(j)]); sum += c; cnt += (c > 0u) ? 1u : 0u; mine = (j == x) ? c : mine; }
        if (sum == G) break;
        __builtin_amdgcn_s_sleep(1);
        if ((++sp & 255u) == 0u) { if (xb_ld(&bar[XB_TMO])) break; if (sp > XB_SPIN_CAP) { atomicAdd(&bar[XB_TMO], 1u); break; } }
    }
    nloc = mine > 0u ? mine : 1u; nx = cnt > 0u ? cnt : 1u;
}
__device__ __forceinline__ void xcd_barrier(const XcdBarrier& b) {
    asm volatile("s_waitcnt vmcnt(0)" ::: "memory");
    __syncthreads();
    if (threadIdx.x == 0) {
        unsigned* bar = b.bar;
        __builtin_amdgcn_s_waitcnt(0);
        unsigned nloc = b.st[0], nx = b.st[1];
        if (nloc == 0u) { xcd_barrier_complete(bar, b.x, nloc, nx); b.st[0] = nloc; b.st[1] = nx; }
        const unsigned old = xb_add(&bar[XB_XSUB(b.x)], 1u);
        const unsigned gen = old / nloc;
        if (old + 1u == (gen + 1u) * nloc) {
            __builtin_amdgcn_fence(__ATOMIC_RELEASE, "agent");
            asm volatile("s_waitcnt vmcnt(0)" ::: "memory");
            const unsigned og = xb_add(&bar[XB_TOP], 1u);
            const unsigned tg = og / nx;
            if (og + 1u == (tg + 1u) * nx) xb_add(&bar[XB_TOPGEN], 1u);
            else XB_SPIN(xb_ld(&bar[XB_TOPGEN]) == tg, bar);
            __builtin_amdgcn_fence(__ATOMIC_ACQUIRE, "agent");
            xb_add(&bar[XB_XGEN(b.x)], 1u);
            asm volatile("s_waitcnt vmcnt(0)" ::: "memory");
        } else {
            XB_SPIN(xb_ld(&bar[XB_XGEN(b.x)]) == gen, bar);
            __builtin_amdgcn_fence(__ATOMIC_ACQUIRE, "agent");
            asm volatile("s_waitcnt vmcnt(0)" ::: "memory");
        }
    }
    __syncthreads();
}
constexpr int MISC_OFF = 147456 - 16;

struct Args { const float* in[26]; float* out; unsigned char* ws; };

__device__ __forceinline__ const Args* args_ptr() {
    const Args* ap = (const Args*)__builtin_amdgcn_kernarg_segment_ptr();
    asm volatile("" : "+s"(ap));
    return ap;
}
#define GAS __attribute__((address_space(1)))
struct ArgsG { GAS const float* in[26]; GAS float* out; GAS unsigned char* ws; };
#define WSP(off) ((unsigned char*)(((const ArgsG*)ap)->ws + (off)))
#define AIN(k) ((const float*)(((const ArgsG*)ap)->in[k]))
#define AOUT ((float*)(((const ArgsG*)ap)->out))

#ifndef REP_GEMM
#define REP_GEMM 1
#endif
#ifndef REP_SYNC
#define REP_SYNC 1
#endif
#ifndef REP_MIX
#define REP_MIX 1
#endif
#ifndef REP_NORM
#define REP_NORM 1
#endif
#ifndef REP_P0
#define REP_P0 1
#endif
#define GSYNC() do { _Pragma("nounroll") for (int r_ = 0; r_ < REP_SYNC; ++r_) { const Args* ap_ = args_ptr(); XcdBarrier b_; b_.bar = (unsigned*)(((const ArgsG*)ap_)->ws); b_.x = xb_xcc_id(); b_.st = (volatile LAS unsigned*)(ldsl + MISC_OFF); xcd_barrier(b_); } } while (0)
#define TID_VARS int tid_ = threadIdx.x; asm volatile("" : "+v"(tid_)); const int tid = tid_, lane = tid & 63, wave = __builtin_amdgcn_readfirstlane(tid >> 6); int G_ = gridDim.x, bx_ = blockIdx.x; asm volatile("" : "+s"(G_), "+s"(bx_)); const int G = G_, bx = bx_; const int gw = bx * NWAVES + wave, NGW = G * NWAVES; (void)lane; (void)gw; (void)NGW; (void)tid
#define GEMM_PHASE(EPI, AOFF, WOFF, NN, KK, OOFF, LDC, RSP) do { _Pragma("nounroll") for (int r_ = 0; r_ < REP_GEMM; ++r_) { const Args* ap = args_ptr(); \
        pg8::Gemm g{(const bf16_t*)WSP(AOFF), (const bf16_t*)WSP(WS_W + (size_t)l * W_LAYER + (WOFF)), TOK, NN, KK}; pg8::StaticOrderRS S; S.init(TOK, NN, (int)gridDim.x, (int)blockIdx.x); S.ssp = RSP; S.tab = ldsl + RSTAB_OFF; \
        pg8::EPI E{(bf16_t*)WSP(OOFF), LDC, ldsl + RSTAB_OFF}; pg8::gemm_phase<pg8::EPI, pg8::StaticOrderRS, true, true>(ldsl, g, S, E); } } while (0)
namespace pg8 {
template <bool FINAL, int GIN, int GOFF, int SCALE2, int BANK> struct EpiNormRes {
    static constexpr bool PERM = true, AFTER_DRAIN = false;
    __device__ __forceinline__ void operator()(const f32x4 (&acc)[2][2][4][2], const Unit& u, int wr_, int wc_, int fr_, int fq_) const {
        int wr = wr_, wc = wc_, fr = fr_, fq = fq_; asm volatile("" : "+s"(wr), "+s"(wc), "+v"(fr), "+v"(fq));
        const Args* ap = args_ptr();
        bf16_t* XB = (bf16_t*)WSP(WS_H); float* out = AOUT; const float* g = AIN(GIN) + GOFF; const float scale = 0.5f * SCALE2;
        unsigned long long* slots = (unsigned long long*)WSP(WS_SLOTS + (size_t)BANK * SLOT_BANK); float* ssp = (float*)WSP(WS_RS);
        PG8_LAS unsigned char* xl = (PG8_LAS unsigned char*)(XL_OFF);
        PG8_LAS float* P = (PG8_LAS float*)xl;
        PG8_LAS float* Sx = (PG8_LAS float*)(xl + 4096);
        const int lane = fr + 16 * fq, wid = wr * 4 + wc;
#pragma unroll
        for (int ai = 0; ai < 2; ++ai)
#pragma unroll
            for (int m = 0; m < 4; ++m) {
                float sq = 0.f;
#pragma unroll
                for (int bj = 0; bj < 2; ++bj)
#pragma unroll
                    for (int n = 0; n < 2; ++n) { const f32x4 x = acc[ai][bj][m][n]; sq += (x[0] * x[0] + x[1] * x[1]) + (x[2] * x[2] + x[3] * x[3]); }
                sq = xsum16(sq); sq = xsum32(sq);
                if (fq == 0) P[(ai * HALF + wr * 64 + m * 16 + fr) * 4 + wc] = sq;
            }
        asm volatile("s_waitcnt lgkmcnt(0)" ::: "memory"); __builtin_amdgcn_s_barrier(); asm volatile("" ::: "memory");
        const int col0 = u.pn * BM + wc * 32 + 8 * fq;
        f32x4 gv[2][2];
#pragma unroll
        for (int bj = 0; bj < 2; ++bj)
#pragma unroll
            for (int n = 0; n < 2; ++n) gv[bj][n] = *(const f32x4*)(g + col0 + bj * HALF + 4 * n);
        u32x4 xpre[4][2];
#pragma unroll
        for (int m = 0; m < 4; ++m)
#pragma unroll
            for (int bj = 0; bj < 2; ++bj) xpre[m][bj] = *(const u32x4*)(XB + (size_t)(u.pm * BM + wr * 64 + m * 16 + fr) * 1024 + col0 + bj * HALF);
        if (lane < 32) {
            const int row = wid * 32 + lane;
            const f32x4 p = *(const PG8_LAS f32x4*)(P + row * 4);
            unsigned long long* sl = slots + (size_t)(u.pm * BM + row) * 4;
            __hip_atomic_store(sl + u.pn, (1ull << 32) | (unsigned long long)__float_as_uint((p[0] + p[1]) + (p[2] + p[3])), __ATOMIC_RELAXED, __HIP_MEMORY_SCOPE_AGENT);
            unsigned long long w0, w1, w2, w3; unsigned sp = 0u;
            for (;;) {
                w0 = __hip_atomic_load(sl + 0, __ATOMIC_RELAXED, __HIP_MEMORY_SCOPE_AGENT); w1 = __hip_atomic_load(sl + 1, __ATOMIC_RELAXED, __HIP_MEMORY_SCOPE_AGENT);
                w2 = __hip_atomic_load(sl + 2, __ATOMIC_RELAXED, __HIP_MEMORY_SCOPE_AGENT); w3 = __hip_atomic_load(sl + 3, __ATOMIC_RELAXED, __HIP_MEMORY_SCOPE_AGENT);
                if ((((w0 >> 32) & (w1 >> 32)) & ((w2 >> 32) & (w3 >> 32))) != 0ull) break;
                __builtin_amdgcn_s_sleep(1); if (++sp > (1u << 20)) break;
            }
            const float t = (__uint_as_float((unsigned)w0) + __uint_as_float((unsigned)w1)) + (__uint_as_float((unsigned)w2) + __uint_as_float((unsigned)w3));
            Sx[row] = scale * rsqrtf(t * (1.f / 1024.f) + 1e-6f);
        }
        asm volatile("s_waitcnt vmcnt(0) lgkmcnt(0)" ::: "memory"); __builtin_amdgcn_s_barrier(); asm volatile("" ::: "memory");
#pragma unroll
        for (int ai = 0; ai < 2; ++ai)
#pragma unroll
            for (int m = 0; m < 4; ++m) {
                const int rl = ai * HALF + wr * 64 + m * 16 + fr; const size_t grow = (size_t)(u.pm * BM + rl);
                const float c = Sx[rl]; float sq = 0.f;
#pragma unroll
                for (int bj = 0; bj < 2; ++bj) {
                    bf16_t* xp = XB + grow * 1024 + col0 + bj * HALF;
                    const u32x4 xw = (ai == 0) ? xpre[m][bj] : *(const u32x4*)xp;
                    const f32x4 x0 = (f32x4){__uint_as_float(xw.x << 16), __uint_as_float(xw.x & 0xffff0000u), __uint_as_float(xw.y << 16), __uint_as_float(xw.y & 0xffff0000u)};
                    const f32x4 x1 = (f32x4){__uint_as_float(xw.z << 16), __uint_as_float(xw.z & 0xffff0000u), __uint_as_float(xw.w << 16), __uint_as_float(xw.w & 0xffff0000u)};
                    const f32x4 v0 = x0 + acc[ai][bj][m][0] * c * gv[bj][0], v1 = x1 + acc[ai][bj][m][1] * c * gv[bj][1];
                    if (FINAL) { float* op = out + grow * 1024 + col0 + bj * HALF; *(f32x4*)op = v0; *(f32x4*)(op + 4) = v1; }
                    else { sq += ((v0[0] * v0[0] + v0[1] * v0[1]) + (v0[2] * v0[2] + v0[3] * v0[3])) + ((v1[0] * v1[0] + v1[1] * v1[1]) + (v1[2] * v1[2] + v1[3] * v1[3]));
                        u32x4 w; w.x = cvt_pk_bf16(v0[0], v0[1]); w.y = cvt_pk_bf16(v0[2], v0[3]); w.z = cvt_pk_bf16(v1[0], v1[1]); w.w = cvt_pk_bf16(v1[2], v1[3]); *(u32x4*)xp = w; }
                }
                if (!FINAL) { sq = xsum16(sq); sq = xsum32(sq); if (fq == 0) P[rl * 4 + wc] = sq; }
            }
        if (!FINAL) {
            asm volatile("s_waitcnt lgkmcnt(0)" ::: "memory"); __builtin_amdgcn_s_barrier(); asm volatile("" ::: "memory");
            if (lane < 32) { const int row = wid * 32 + lane; const f32x4 p = *(const PG8_LAS f32x4*)(P + row * 4); ssp[(size_t)(u.pm * BM + row) * 4 + u.pn] = (p[0] + p[1]) + (p[2] + p[3]); }
        }
    }
};

}

#define GEMM_FUSED(FINAL, AOFF, WOFF, KK, GIN, GOFF, SCALE2, BANK) do { const Args* ap = args_ptr(); \
        pg8::Gemm g{(const bf16_t*)WSP(AOFF), (const bf16_t*)WSP(WS_W + (size_t)l * W_LAYER + (WOFF)), TOK, DM, KK}; pg8::StaticOrder S; S.init(TOK, DM, (int)gridDim.x, (int)blockIdx.x); \
        typedef pg8::EpiNormRes<FINAL, GIN, GOFF, SCALE2, BANK> EpiT; EpiT E; \
        pg8::gemm_phase<EpiT, pg8::StaticOrder, true, true>(ldsl, g, S, E); } while (0)
template <int l> __device__ __forceinline__ void layer_body(unsigned char* lds, LAS unsigned char* ldsl, cg::grid_group& grid) {
        GEMM_PHASE(EpiSwiGLU, WS_H, WO_GU1, 2 * FF, DM, WS_ACT, FF, (const float*)WSP(WS_RS));
        GSYNC();
        GEMM_FUSED(false, WS_ACT, WO_DOWN1, FF, 4, l * DM, 1, 3 * l + 0);
        GSYNC();
        GEMM_PHASE(EpiBf16S, WS_H, WO_IN, NP, DM, WS_PROJ, NP, (const float*)WSP(WS_RS));
        GSYNC();
        _Pragma("nounroll") for (int rm_ = 0; rm_ < REP_MIX; ++rm_) {
#ifndef SKIP_LRU
            { TID_VARS; const Args* ap = args_ptr();
              for (int it = gw; it < NB * 64 * 4; it += NGW)
                lru_local_item(it, lane, lds + wave * 17408, (const bf16_t*)WSP(WS_PROJ), AIN(7) + l * 4 * 256, AIN(8) + l * 256, AIN(9) + l * 16384, AIN(10) + l * 256,
                               AIN(11) + l * 16384, AIN(12) + l * 256, AIN(13) + l * 256, (unsigned*)WSP(WS_PH), (float*)WSP(WS_AGG)); }
#endif
            __syncthreads();
#ifndef SKIP_ATTN
            { TID_VARS; const Args* ap = args_ptr();
              for (int it = bx; it < NB * 2 * 32; it += G) attn_item(it, lds, tid, lane, wave, (const bf16_t*)WSP(WS_PROJ), AIN(14) + l * 8, (bf16_t*)WSP(WS_YMIX)); }
#endif
#ifndef SKIP_CONF
            { TID_VARS; const Args* ap = args_ptr();
              conf_phase(bx, G, lds, tid, lane, wave, (const bf16_t*)WSP(WS_PROJ), AIN(15) + l * 31 * 256, AIN(16) + l * 256, AIN(17) + l * 256, AIN(18) + l * 256, AIN(19) + l * 1024 + 768, (bf16_t*)WSP(WS_YMIX)); }
#endif
        }
        GSYNC();
#ifndef SKIP_MIX2
        { TID_VARS; const Args* ap = args_ptr();
          for (int it = bx; it < NB * 64; it += G) mix2_item(it, lds, tid, lane, wave, (const bf16_t*)WSP(WS_PROJ), (const unsigned*)WSP(WS_PH), (const float*)WSP(WS_AGG), AIN(19) + l * 1024, (bf16_t*)WSP(WS_YMIX)); }
#endif
        GSYNC();
        GEMM_FUSED(false, WS_YMIX, WO_OUT, DM, 21, l * DM, 2, 3 * l + 1);
        GSYNC();
        GEMM_PHASE(EpiSwiGLU, WS_H, WO_GU2, 2 * FF, DM, WS_ACT, FF, (const float*)WSP(WS_RS));
        GSYNC();
        if (l == 0) { GEMM_FUSED(false, WS_ACT, WO_DOWN2, FF, 25, 0, 1, 3 * l + 2); GSYNC(); }
        else GEMM_FUSED(true, WS_ACT, WO_DOWN2, FF, 25, DM, 1, 3 * l + 2);
}

__global__ void __launch_bounds__(NWAVES * 64, 2) hymba_fwd(Args args_unused) {
    extern __shared__ __attribute__((aligned(16))) unsigned char lds[];
    cg::grid_group grid = cg::this_grid();
    LAS unsigned char* ldsl = (LAS unsigned char*)lds;
    if (threadIdx.x < 2) ((volatile LAS unsigned*)(ldsl + MISC_OFF))[threadIdx.x] = 0u;
    if (blockIdx.x == 0) { const Args* ap = args_ptr(); for (int i = threadIdx.x; i < XCD_BAR_WORDS; i += NWAVES * 64) ((unsigned*)WSP(0))[i] = 0u; }
    { const Args* ap = args_ptr(); u32x4* cz = (u32x4*)WSP(WS_SLOTS); for (int i = blockIdx.x * (NWAVES * 64) + threadIdx.x; i < (int)(6 * SLOT_BANK / 16); i += gridDim.x * NWAVES * 64) cz[i] = (u32x4){0u, 0u, 0u, 0u}; }
    __syncthreads();

    _Pragma("nounroll") for (int rp_ = 0; rp_ < REP_P0; ++rp_) {
        TID_VARS; const Args* ap = args_ptr();
        constexpr int I_GU = (DM / 64) * (2 * FF / 64), I_DOWN = (FF / 64) * (DM / 64), I_IN = (DM / 64) * (NP / 64), I_OUT = (DM / 64) * (DM / 64);
        constexpr int I_LAYER = 2 * I_GU + 2 * I_DOWN + I_IN + I_OUT;
        for (int it = gw; it < 2 * I_LAYER; it += NGW) {
            const int l = it / I_LAYER; int r = it % I_LAYER;
            unsigned char* wb = WSP(WS_W + (size_t)l * W_LAYER);
            if (r < I_GU) { transpose_item(AIN(2) + (size_t)l * DM * 2 * FF, DM, 2 * FF, (bf16_t*)(wb + WO_GU1), true, AIN(1) + l * DM, r, lane); continue; } r -= I_GU;
            if (r < I_GU) { transpose_item(AIN(23) + (size_t)l * DM * 2 * FF, DM, 2 * FF, (bf16_t*)(wb + WO_GU2), true, AIN(22) + l * DM, r, lane); continue; } r -= I_GU;
            if (r < I_DOWN) { transpose_item(AIN(3) + (size_t)l * FF * DM, FF, DM, (bf16_t*)(wb + WO_DOWN1), false, nullptr, r, lane); continue; } r -= I_DOWN;
            if (r < I_DOWN) { transpose_item(AIN(24) + (size_t)l * FF * DM, FF, DM, (bf16_t*)(wb + WO_DOWN2), false, nullptr, r, lane); continue; } r -= I_DOWN;
            if (r < I_IN) { transpose_item(AIN(6) + (size_t)l * DM * NP, DM, NP, (bf16_t*)(wb + WO_IN), false, AIN(5) + l * DM, r, lane); continue; } r -= I_IN;
            transpose_item(AIN(20) + (size_t)l * DM * DM, DM, DM, (bf16_t*)(wb + WO_OUT), false, nullptr, r, lane);
        }
        norm_phase<0>(gw, NGW, lane, AIN(0), nullptr, (bf16_t*)WSP(WS_H), nullptr, nullptr, 1.f, (float*)WSP(WS_RS));
    }
    grid.sync();
    if (threadIdx.x == 0) { const Args* ap = args_ptr(); (void)xb_add(&((unsigned*)WSP(0))[XB_XCNT(xb_xcc_id())], 1u); }

    layer_body<0>(lds, ldsl, grid);
    layer_body<1>(lds, ldsl, grid);
}

extern "C" void kernel_launch(void* const* d_in, const int* in_sizes, int n_in, void* d_out, int out_size, void* d_ws, size_t ws_size, hipStream_t stream) {
    static int grid = 0;
    if (grid == 0) {
        if (n_in != 26 || out_size != TOK * DM || ws_size < WS_END) { fprintf(stderr, "kernel_launch: unexpected shapes (n_in %d out %d ws %zu)\n", n_in, out_size, ws_size); grid = -1; return; }
        int dev = 0, cus = 0, per_cu = 0;
        hipGetDevice(&dev);
        hipDeviceGetAttribute(&cus, hipDeviceAttributeMultiprocessorCount, dev);
        hipFuncSetAttribute((const void*)hymba_fwd, hipFuncAttributeMaxDynamicSharedMemorySize, LDS_BYTES);
        hipOccupancyMaxActiveBlocksPerMultiprocessor(&per_cu, (const void*)hymba_fwd, NWAVES * 64, LDS_BYTES);
        if (per_cu < 1) { fprintf(stderr, "kernel_launch: occupancy query says %d blocks/CU\n", per_cu); per_cu = 1; }
        (void)hipGetLastError();
        grid = cus;
    }
    if (grid < 0) return;
    Args a{};
    for (int i = 0; i < 26; ++i) a.in[i] = (const float*)d_in[i];
    a.out = (float*)d_out; a.ws = (unsigned char*)d_ws;
    void* params[] = {&a};
    hipError_t e = hipLaunchCooperativeKernel((const void*)hymba_fwd, dim3(grid), dim3(NWAVES * 64), params, LDS_BYTES, stream);
    if (e != hipSuccess) fprintf(stderr, "cooperative launch failed: %s (grid %d)\n", hipGetErrorString(e), grid);
}
```

```cpp
#include <hip/hip_runtime.h>
#include <hip/hip_cooperative_groups.h>
#include <cstdio>
#include <cstdint>
namespace cg = cooperative_groups;

namespace pg8 {
#define PG8_LAS __attribute__((address_space(3)))
typedef unsigned short bf16_t;
typedef short bf16x8 __attribute__((ext_vector_type(8)));
typedef float f32x4 __attribute__((ext_vector_type(4)));
typedef unsigned u32x4 __attribute__((ext_vector_type(4)));
constexpr int BM = 256, BK = 64, HALF = 128, HTB = HALF * BK * 2, STAGE_BYTES = 8 * HTB, NXCD = 8, WGM = 8;

__host__ __device__ __forceinline__ int lds_byte(int r, int c) { const int st = (r >> 4) * 2 + (c >> 5), rr = r & 15, cc = c & 31, ob = rr * 64 + cc * 2; return st * 1024 + (ob ^ (((ob >> 9) & 1) << 5)); }
__host__ __device__ __forceinline__ void stage_rc(int b, int& R, int& C) { const int st = b / 1024, sb = b % 1024, swz = sb ^ (((sb >> 9) & 1) << 5); R = (st >> 1) * 16 + swz / 64; C = (st & 1) * 32 + (swz % 64) / 2; }
__host__ __device__ __forceinline__ int perm32(int rho) { const int n = rho >> 4, i = rho & 15; return 8 * (i >> 2) + 4 * n + (i & 3); }

struct Unit { int pm, pn, par; };
struct Gemm { const bf16_t* A; const bf16_t* Bt; int M, N, K; };

struct StaticOrder {
    int nM, nN, nwg, G, c;
    __host__ __device__ void init(int M, int N, int G_, int c_) { nM = M / BM; nN = N / BM; nwg = nM * nN; G = G_; c = c_; }
    __host__ __device__ bool next(int i, Unit& u) const {
        const long L = (long)i * G + c; if (L >= nwg) return false;
        int wgid = (int)L; { const int q = nwg / NXCD, r = nwg % NXCD, xcd = wgid % NXCD, off = wgid / NXCD; wgid = (xcd < r ? xcd * (q + 1) : r * (q + 1) + (xcd - r) * q) + off; }
        const int nig = WGM * nN, gid = wgid / nig, fm = gid * WGM, gsz = (nM - fm) < WGM ? (nM - fm) : WGM;
        u.pm = fm + ((wgid % nig) % gsz); u.pn = (wgid % nig) / gsz; u.par = i & 1; return true;
    }
    __device__ __forceinline__ void a_ready(const Unit&) const {}
    __device__ __forceinline__ void done(const Unit&) const {}
};

struct StaticOrderRS : StaticOrder {
    const float* ssp; PG8_LAS unsigned char* tab;
    __device__ __forceinline__ void a_ready(const Unit& u) const {
        const int tid = threadIdx.x; const int wid = __builtin_amdgcn_readfirstlane(tid >> 6), lane = tid & 63;
        if (wid < 4) __builtin_amdgcn_global_load_lds((const unsigned*)(ssp + ((size_t)u.pm * BM + wid * 64 + lane) * 4), (PG8_LAS unsigned*)(tab + u.par * 4096 + wid * 1024), 16, 0, 0);
    }
};

__device__ __forceinline__ unsigned cvt_pk_bf16(float lo, float hi) { unsigned r; asm volatile("v_cvt_pk_bf16_f32 %0, %1, %2" : "=v"(r) : "v"(lo), "v"(hi)); return r; }

template <bool SCALE> struct EpiBf16T {
    static constexpr bool PERM = true, AFTER_DRAIN = false;
    bf16_t* O; int ldc; PG8_LAS unsigned char* rs;
    __device__ __forceinline__ void operator()(const f32x4 (&acc)[2][2][4][2], const Unit& u, int wr, int wc, int fr, int fq) const {
        const int row0 = u.pm * BM + wr * 64 + fr; const int col0 = u.pn * BM + wc * 32 + 8 * fq;
#pragma unroll
        for (int ai = 0; ai < 2; ++ai)
#pragma unroll
            for (int m = 0; m < 4; ++m) { const int row = row0 + ai * HALF + m * 16; bf16_t* rowp = O + (size_t)row * ldc + col0;
                float sc = 1.f; if (SCALE) { const f32x4 p4 = *(const PG8_LAS f32x4*)(rs + u.par * 4096 + (wr * 64 + fr + ai * HALF + m * 16) * 16); sc = rsqrtf(((p4[0] + p4[1]) + (p4[2] + p4[3])) * (1.f / 1024.f) + 1e-6f); }
#pragma unroll
                for (int bj = 0; bj < 2; ++bj) { const f32x4 v0 = acc[ai][bj][m][0] * sc, v1 = acc[ai][bj][m][1] * sc;
                    u32x4 w; w.x = cvt_pk_bf16(v0[0], v0[1]); w.y = cvt_pk_bf16(v0[2], v0[3]); w.z = cvt_pk_bf16(v1[0], v1[1]); w.w = cvt_pk_bf16(v1[2], v1[3]);
                    *(u32x4*)(rowp + bj * HALF) = w; } }
    }
};
typedef EpiBf16T<false> EpiBf16; typedef EpiBf16T<true> EpiBf16S;
typedef float f32x2 __attribute__((ext_vector_type(2)));
__device__ __forceinline__ float silu_mul(float g, float u) { return g * u * __builtin_amdgcn_rcpf(1.f + __expf(-g)); }
struct EpiSwiGLU {
    static constexpr bool PERM = true, AFTER_DRAIN = false;
    bf16_t* O; int ldc; PG8_LAS unsigned char* rs;
    __device__ __forceinline__ void operator()(const f32x4 (&acc)[2][2][4][2], const Unit& u, int wr, int wc, int fr, int fq) const {
        const int row0 = u.pm * BM + wr * 64 + fr; const int col0 = u.pn * HALF + wc * 32 + 8 * fq;
#pragma unroll
        for (int ai = 0; ai < 2; ++ai)
#pragma unroll
            for (int m = 0; m < 4; ++m) { const int row = row0 + ai * HALF + m * 16; bf16_t* rowp = O + (size_t)row * ldc + col0;
                const f32x4 p4 = *(const PG8_LAS f32x4*)(rs + u.par * 4096 + (wr * 64 + fr + ai * HALF + m * 16) * 16); const float sc = rsqrtf(((p4[0] + p4[1]) + (p4[2] + p4[3])) * (1.f / 1024.f) + 1e-6f);
                const float kk = -1.4426950408889634f * sc, sc2 = sc * sc;
                u32x4 w; unsigned wq[4];
#pragma unroll
                for (int q = 0; q < 4; ++q) { const int n = q >> 1, e0 = (q & 1) * 2;
                    const f32x2 gg = (f32x2){acc[ai][0][m][n][e0], acc[ai][0][m][n][e0 + 1]}, uu = (f32x2){acc[ai][1][m][n][e0], acc[ai][1][m][n][e0 + 1]};
                    const f32x2 t = gg * kk; f32x2 d; d.x = __builtin_amdgcn_exp2f(t.x); d.y = __builtin_amdgcn_exp2f(t.y); d = d + 1.0f;
                    f32x2 r; r.x = __builtin_amdgcn_rcpf(d.x); r.y = __builtin_amdgcn_rcpf(d.y);
                    const f32x2 o = ((gg * uu) * sc2) * r;
                    wq[q] = cvt_pk_bf16(o.x, o.y); }
                w.x = wq[0]; w.y = wq[1]; w.z = wq[2]; w.w = wq[3];
                *(u32x4*)rowp = w; }
    }
};


template <class Epi, class Sched, bool ALIGN_EPI = false, bool SP2 = false>
__device__ __forceinline__ void gemm_phase(PG8_LAS unsigned char* lds, const Gemm g, const Sched& S, const Epi& E) {
    int tid_ = threadIdx.x; asm volatile("" : "+v"(tid_));
    const int tid = tid_, wid = __builtin_amdgcn_readfirstlane(tid >> 6), lane = tid & 63, wr = wid >> 2, wc = wid & 3, fr = lane & 15, fq = lane >> 4;
    const int K = g.K, nt = K / BK;
    unsigned voffA[2], voffB[2];
#pragma unroll
    for (int i = 0; i < 2; ++i) { int R, C; stage_rc(tid * 16 + i * 8192, R, C); const int Rb = Epi::PERM ? ((R & ~31) + perm32(R & 31)) : R;
        voffA[i] = (unsigned)(R * K + C) * 2u; voffB[i] = (unsigned)(Rb * K + C) * 2u; }
    const size_t kstep = (size_t)(BK * 2);
    const size_t hstep = (size_t)HALF * K * 2;
    const size_t tstep = 2 * hstep;
    const unsigned ldsw = (unsigned)wid * 1024u;
    const int aoff = lds_byte(wr * 64 + fr, fq * 8), boff = lds_byte(wc * 32 + fr, fq * 8);
#define PG8_SA(b, h) (((b) * 2 + (h)) * HTB)
#define PG8_SB(b, h) ((4 + (b) * 2 + (h)) * HTB)
#define PG8_STAGE(bufoff, gbase, voff) do { _Pragma("unroll") for (int _i = 0; _i < 2; ++_i) \
        __builtin_amdgcn_global_load_lds((const unsigned*)((const char*)(gbase) + (voff)[_i]), (PG8_LAS unsigned*)(lds + (bufoff) + ldsw + _i * 8192), 16, 0, 0); } while (0)
#define PG8_LDA(dst, b, h) do { _Pragma("unroll") for (int m = 0; m < 4; ++m) _Pragma("unroll") for (int k = 0; k < 2; ++k) dst[m][k] = *(const PG8_LAS bf16x8*)(lds + PG8_SA(b, h) + aoff + m * 2048 + k * 1024); } while (0)
#define PG8_LDB(dst, b, h) do { _Pragma("unroll") for (int n = 0; n < 2; ++n) _Pragma("unroll") for (int k = 0; k < 2; ++k) dst[n][k] = *(const PG8_LAS bf16x8*)(lds + PG8_SB(b, h) + boff + n * 2048 + k * 1024); } while (0)
#define PG8_MMA(ai, bj, At, Bt) do { __builtin_amdgcn_s_setprio(1); _Pragma("unroll") for (int m = 0; m < 4; ++m) _Pragma("unroll") for (int n = 0; n < 2; ++n) _Pragma("unroll") for (int k = 0; k < 2; ++k) \
        acc[ai][bj][m][n] = __builtin_amdgcn_mfma_f32_16x16x32_bf16(Bt[n][k], At[m][k], acc[ai][bj][m][n], 0, 0, 0); __builtin_amdgcn_s_setprio(0); } while (0)
#define PG8_WAIT_V(n) asm volatile("s_waitcnt vmcnt(" #n ")" ::: "memory")
#define PG8_WAIT_L(n) asm volatile("s_waitcnt lgkmcnt(" #n ")" ::: "memory")
#define PG8_BAR __builtin_amdgcn_s_barrier()
#define PG8_SCHED __builtin_amdgcn_sched_barrier(0)
    Unit cur, nxt; int ui = 0;
    if (!S.next(0, cur)) return;
    f32x4 acc[2][2][4][2];
#pragma unroll
    for (int a = 0; a < 2; ++a)
#pragma unroll
        for (int b = 0; b < 2; ++b)
#pragma unroll
            for (int m = 0; m < 4; ++m)
#pragma unroll
                for (int n = 0; n < 2; ++n) acc[a][b][m][n] = (f32x4){0.f, 0.f, 0.f, 0.f};
    bf16x8 At[4][2], B0[2][2], B1[2][2];
    const char* cA = (const char*)g.A + (size_t)cur.pm * tstep; const char* cB = (const char*)g.Bt + (size_t)cur.pn * tstep;
    S.a_ready(cur);
    if constexpr (SP2) {
        PG8_STAGE(PG8_SB(0, 0), cB, voffB); PG8_STAGE(PG8_SB(0, 1), cB + hstep, voffB); PG8_STAGE(PG8_SA(0, 0), cA, voffA); PG8_STAGE(PG8_SA(0, 1), cA + hstep, voffA);
        if (wr == 1) PG8_BAR;
        PG8_WAIT_V(2); PG8_BAR;
        PG8_STAGE(PG8_SB(1, 0), cB + kstep, voffB); PG8_STAGE(PG8_SA(1, 0), cA + kstep, voffA); PG8_STAGE(PG8_SB(1, 1), cB + hstep + kstep, voffB);
        PG8_WAIT_V(6); PG8_BAR;
    } else {
        PG8_STAGE(PG8_SB(0, 0), cB, voffB); PG8_STAGE(PG8_SA(0, 0), cA, voffA); PG8_STAGE(PG8_SB(0, 1), cB + hstep, voffB); PG8_STAGE(PG8_SA(0, 1), cA + hstep, voffA);
        if (wr == 1) PG8_BAR;
        PG8_WAIT_V(4); PG8_BAR;
        PG8_STAGE(PG8_SB(1, 0), cB + kstep, voffB); PG8_STAGE(PG8_SA(1, 0), cA + kstep, voffA); PG8_STAGE(PG8_SB(1, 1), cB + hstep + kstep, voffB);
        PG8_WAIT_V(6); PG8_BAR;
    }
    for (;;) {
        const bool has_next = S.next(ui + 1, nxt);
        const char* nA = has_next ? (const char*)g.A + (size_t)nxt.pm * tstep : cA; const char* nB = has_next ? (const char*)g.Bt + (size_t)nxt.pn * tstep : cB;
        asm volatile(".p2align 6\n\ts_nop 0\n\ts_nop 0\n\ts_nop 0\n\ts_nop 0\n\ts_nop 0\n\ts_nop 0\n\ts_nop 0\n\ts_nop 0" ::: );
        for (int t = 0; t < nt; t += 2) {
            const bool last = (t == nt - 2);
            const char* a1 = cA + (size_t)(t + 1) * kstep;
            const char* a2 = last ? nA : cA + (size_t)(t + 2) * kstep; const char* b2 = last ? nB : cB + (size_t)(t + 2) * kstep;
            const char* a3 = a2 + kstep; const char* b3 = b2 + kstep;
            if (last && has_next) S.a_ready(nxt);
            if constexpr (SP2) {
            PG8_LDB(B0, 0, 0); PG8_LDB(B1, 0, 1); PG8_SCHED; PG8_LDA(At, 0, 0); PG8_STAGE(PG8_SA(1, 1), a1 + hstep, voffA);
            PG8_WAIT_V(8); PG8_WAIT_L(0); PG8_BAR; PG8_MMA(0, 0, At, B0); PG8_MMA(0, 1, At, B1); PG8_BAR; PG8_SCHED;
            PG8_LDA(At, 0, 1); PG8_STAGE(PG8_SB(0, 0), b2, voffB); PG8_STAGE(PG8_SB(0, 1), b2 + hstep, voffB); PG8_STAGE(PG8_SA(0, 0), a2, voffA);
            PG8_WAIT_V(8); PG8_WAIT_L(0); PG8_BAR; PG8_MMA(1, 0, At, B0); PG8_MMA(1, 1, At, B1); PG8_BAR; PG8_SCHED;
            PG8_LDB(B0, 1, 0); PG8_LDB(B1, 1, 1); PG8_SCHED; PG8_LDA(At, 1, 0); PG8_STAGE(PG8_SA(0, 1), a2 + hstep, voffA);
            PG8_WAIT_V(8); PG8_WAIT_L(0); PG8_BAR; PG8_MMA(0, 0, At, B0); PG8_MMA(0, 1, At, B1); PG8_BAR; PG8_SCHED;
            PG8_LDA(At, 1, 1); PG8_STAGE(PG8_SB(1, 0), b3, voffB); PG8_STAGE(PG8_SB(1, 1), b3 + hstep, voffB); PG8_STAGE(PG8_SA(1, 0), a3, voffA);
            PG8_WAIT_V(8); PG8_WAIT_L(0); PG8_BAR; PG8_MMA(1, 0, At, B0); PG8_MMA(1, 1, At, B1); PG8_BAR; PG8_SCHED;
            } else {
            PG8_LDB(B0, 0, 0); PG8_SCHED; PG8_LDA(At, 0, 0); PG8_STAGE(PG8_SA(1, 1), a1 + hstep, voffA);
            PG8_WAIT_L(8); PG8_BAR; PG8_WAIT_L(0); PG8_MMA(0, 0, At, B0); PG8_BAR; PG8_SCHED;
            PG8_LDB(B1, 0, 1); PG8_STAGE(PG8_SB(0, 0), b2, voffB);
            PG8_BAR; PG8_WAIT_L(0); PG8_MMA(0, 1, At, B1); PG8_BAR;
            PG8_LDA(At, 0, 1); PG8_STAGE(PG8_SA(0, 0), a2, voffA);
            PG8_BAR; PG8_WAIT_L(0); PG8_MMA(1, 0, At, B0); PG8_BAR; PG8_SCHED;
            PG8_STAGE(PG8_SB(0, 1), b2 + hstep, voffB);
            PG8_WAIT_V(6); PG8_BAR; PG8_MMA(1, 1, At, B1); PG8_BAR;
            PG8_LDB(B0, 1, 0); PG8_SCHED; PG8_LDA(At, 1, 0); PG8_STAGE(PG8_SA(0, 1), a2 + hstep, voffA);
            PG8_WAIT_L(8); PG8_BAR; PG8_WAIT_L(0); PG8_MMA(0, 0, At, B0); PG8_BAR; PG8_SCHED;
            PG8_LDB(B1, 1, 1); PG8_STAGE(PG8_SB(1, 0), b3, voffB);
            PG8_BAR; PG8_WAIT_L(0); PG8_MMA(0, 1, At, B1); PG8_BAR;
            PG8_LDA(At, 1, 1); PG8_STAGE(PG8_SA(1, 0), a3, voffA);
            PG8_BAR; PG8_WAIT_L(0); PG8_MMA(1, 0, At, B0); PG8_BAR; PG8_SCHED;
            PG8_STAGE(PG8_SB(1, 1), b3 + hstep, voffB);
            PG8_WAIT_V(6); PG8_BAR; PG8_MMA(1, 1, At, B1); PG8_BAR;
            }
        }
        if constexpr (ALIGN_EPI) { if (wr == 0) PG8_BAR; }
        if constexpr (!Epi::AFTER_DRAIN) { E(acc, cur, wr, wc, fr, fq); S.done(cur); }
        if (!has_next) break;
#pragma unroll
        for (int a = 0; a < 2; ++a)
#pragma unroll
            for (int b = 0; b < 2; ++b)
#pragma unroll
                for (int m = 0; m < 4; ++m)
#pragma unroll
                    for (int n = 0; n < 2; ++n) acc[a][b][m][n] = (f32x4){0.f, 0.f, 0.f, 0.f};
        cur = nxt; cA = nA; cB = nB; ++ui;
        if constexpr (ALIGN_EPI) { if (wr == 1) PG8_BAR; }
    }
    PG8_WAIT_V(0);
    if constexpr (!ALIGN_EPI) { if (wr == 0) PG8_BAR; }
    PG8_BAR;
#undef PG8_SA
#undef PG8_SB
#undef PG8_STAGE
#undef PG8_LDA
#undef PG8_LDB
#undef PG8_MMA
#undef PG8_WAIT_V
#undef PG8_WAIT_L
#undef PG8_BAR
#undef PG8_SCHED
}
}

typedef unsigned short bf16_t;
typedef float f32x4 __attribute__((ext_vector_type(4)));
typedef unsigned u32x4 __attribute__((ext_vector_type(4)));
typedef unsigned u32x2 __attribute__((ext_vector_type(2)));
typedef short bf16x8 __attribute__((ext_vector_type(8)));
#define LAS __attribute__((address_space(3)))

constexpr int NWAVES = 8;
constexpr int SEQ = 4096, NB = 8, TOK = NB * SEQ, DM = 1024, FF = 2816, NP = 1792;
constexpr int OFF_GATE = 256, OFF_Q = 512, OFF_K = 1024, OFF_V = 1152, OFF_GLU = 1280;
constexpr float NORM_EPS = 1e-6f, LN_EPS = 1e-5f;

constexpr size_t MiB = 1u << 20;
constexpr size_t W_GU = (size_t)2 * FF * DM * 2, W_DOWN = (size_t)DM * FF * 2, W_IN = (size_t)NP * DM * 2, W_OUT = (size_t)DM * DM * 2;
constexpr size_t WO_GU1 = 0, WO_DOWN1 = WO_GU1 + W_GU, WO_IN = WO_DOWN1 + W_DOWN, WO_OUT = WO_IN + W_IN, WO_GU2 = WO_OUT + W_OUT, WO_DOWN2 = WO_GU2 + W_GU, W_LAYER = WO_DOWN2 + W_DOWN;
constexpr size_t WS_W = 1 * MiB;
constexpr size_t WS_H = 80 * MiB;
constexpr size_t WS_Y = 144 * MiB;
constexpr size_t WS_ACT = 208 * MiB;
constexpr size_t WS_PROJ = 208 * MiB;
constexpr size_t WS_YMIX = 320 * MiB;
constexpr size_t WS_PH = 384 * MiB;
constexpr size_t WS_AGG = 416 * MiB;
constexpr size_t WS_RS = 417 * MiB;
constexpr size_t WS_SLOTS = 418 * MiB;
constexpr size_t SLOT_BANK = (size_t)TOK * 4 * 8;
constexpr size_t WS_END = 424 * MiB;
static_assert(WS_W + 2 * W_LAYER <= WS_H, "weights fit");

constexpr size_t CTL_CNT = 65536;
constexpr size_t CTL_CNT_BYTES = 6 * 32768;
constexpr size_t CTL_SLOTS = 524288;
constexpr int XL_OFF = 131072 + 1024;
constexpr int RSTAB_OFF = 131072 + 7168;
constexpr int LDS_BYTES = 147456;

__device__ __forceinline__ float bflo(unsigned u) { return __uint_as_float(u << 16); }
__device__ __forceinline__ float bfhi(unsigned u) { return __uint_as_float(u & 0xffff0000u); }
__device__ __forceinline__ float bf1(bf16_t u) { return __uint_as_float((unsigned)u << 16); }
__device__ __forceinline__ unsigned pk2(float lo, float hi) { return pg8::cvt_pk_bf16(lo, hi); }
#define DPP_ADD(v, ctrl) ((v) + __builtin_bit_cast(float, __builtin_amdgcn_update_dpp(0, __builtin_bit_cast(int, (v)), (ctrl), 0xF, 0xF, false)))
__device__ __forceinline__ float wave_sum(float v) {
    v = DPP_ADD(v, 0xB1);
    v = DPP_ADD(v, 0x4E);
    v = DPP_ADD(v, 0x141);
    v = DPP_ADD(v, 0x140);
    return (__builtin_bit_cast(float, __builtin_amdgcn_readlane(__builtin_bit_cast(int, v), 0)) + __builtin_bit_cast(float, __builtin_amdgcn_readlane(__builtin_bit_cast(int, v), 16))) +
           (__builtin_bit_cast(float, __builtin_amdgcn_readlane(__builtin_bit_cast(int, v), 32)) + __builtin_bit_cast(float, __builtin_amdgcn_readlane(__builtin_bit_cast(int, v), 48)));
}
__device__ __forceinline__ float sigmoidf_(float x) { return __builtin_amdgcn_rcpf(1.f + __expf(-x)); }
__device__ __forceinline__ float dot4(f32x4 a) { return (a.x * a.x + a.y * a.y) + (a.z * a.z + a.w * a.w); }
__device__ __forceinline__ float gelu_tanh(float x) {
    const float z = 0.7978845608028654f * (x + 0.044715f * x * x * x);
    const float t = 1.f - 2.f * __builtin_amdgcn_rcpf(__expf(2.f * z) + 1.f);
    return 0.5f * x * (1.f + t);
}

__device__ __forceinline__ void transpose_item(const float* W, int K, int N, bf16_t* WT, bool gu, const float* gain, int item, int lane) {
    const int nblk = N / 64, kb = item / nblk, nb = item % nblk, k0 = 64 * kb, n = 64 * nb + lane;
    float v[64];
    const float* wp = W + (size_t)k0 * N + n;
#pragma unroll
    for (int i = 0; i < 64; ++i) v[i] = __builtin_nontemporal_load(wp + (size_t)i * N);
    if (gain) {
#pragma unroll
        for (int i = 0; i < 64; ++i) v[i] *= gain[k0 + i]; }
    int row = n;
    if (gu) { const int bj = n / FF, r = n % FF, pn = r / 128, j = r % 128; row = 256 * pn + 128 * bj + j; }
    bf16_t* dst = WT + (size_t)row * K + k0;
#pragma unroll
    for (int c = 0; c < 8; ++c) { u32x4 o; o.x = pk2(v[8 * c], v[8 * c + 1]); o.y = pk2(v[8 * c + 2], v[8 * c + 3]); o.z = pk2(v[8 * c + 4], v[8 * c + 5]); o.w = pk2(v[8 * c + 6], v[8 * c + 7]);
        *(u32x4*)(dst + 8 * c) = o; }
}

template <int MODE>
__device__ __forceinline__ void norm_phase(int gw, int NGW, int lane, const float* xin, float* xout, bf16_t* XB, const bf16_t* Y, const float* post_g, float scale, float* rs) {
    constexpr bool XF32 = (MODE == 0 || MODE == 3), HASY = (MODE != 0);
    f32x4 qg[4];
#pragma unroll
    for (int j = 0; j < 4; ++j) qg[j] = HASY ? ((const f32x4*)post_g)[lane + 64 * j] : (f32x4){0.f, 0.f, 0.f, 0.f};
    f32x4 v[4]; u32x2 xw[4], yw[4];
    if (gw < TOK) {
        if (XF32) { const f32x4* xr = (const f32x4*)(xin + (size_t)gw * DM) + lane;
#pragma unroll
            for (int j = 0; j < 4; ++j) v[j] = __builtin_nontemporal_load(xr + 64 * j); }
        else { const u32x2* xr = (const u32x2*)(XB + (size_t)gw * DM) + lane;
#pragma unroll
            for (int j = 0; j < 4; ++j) xw[j] = xr[64 * j]; }
        if (HASY) { const u32x2* yr = (const u32x2*)(Y + (size_t)gw * DM) + lane;
#pragma unroll
            for (int j = 0; j < 4; ++j) yw[j] = yr[64 * j]; }
    }
    for (int m = gw; m < TOK; m += NGW) {
        f32x4 vn[4]; u32x2 xwn[4], ywn[4];
        const int mn = (m + NGW < TOK) ? m + NGW : m;
        {
            if (XF32) { const f32x4* xr = (const f32x4*)(xin + (size_t)mn * DM) + lane;
#pragma unroll
                for (int j = 0; j < 4; ++j) vn[j] = __builtin_nontemporal_load(xr + 64 * j); }
            else { const u32x2* xr = (const u32x2*)(XB + (size_t)mn * DM) + lane;
#pragma unroll
                for (int j = 0; j < 4; ++j) xwn[j] = xr[64 * j]; }
            if (HASY) { const u32x2* yr = (const u32x2*)(Y + (size_t)mn * DM) + lane;
#pragma unroll
                for (int j = 0; j < 4; ++j) ywn[j] = yr[64 * j]; }
        }
        if (!XF32) {
#pragma unroll
            for (int j = 0; j < 4; ++j) v[j] = (f32x4){bflo(xw[j].x), bfhi(xw[j].x), bflo(xw[j].y), bfhi(xw[j].y)};
        }
        if (HASY) {
            f32x4 y[4]; float ss = 0.f;
#pragma unroll
            for (int j = 0; j < 4; ++j) { const u32x2 w = yw[j]; y[j] = (f32x4){bflo(w.x), bfhi(w.x), bflo(w.y), bfhi(w.y)}; ss += dot4(y[j]); }
            ss = wave_sum(ss);
            const float r = rsqrtf(ss * (1.f / DM) + NORM_EPS) * scale;
#pragma unroll
            for (int j = 0; j < 4; ++j) v[j] = v[j] + y[j] * r * qg[j];
        }
        if (MODE == 2) {
            f32x4* xo = (f32x4*)(xout + (size_t)m * DM) + lane;
#pragma unroll
            for (int j = 0; j < 4; ++j) xo[64 * j] = v[j];
        } else {
            float ss = 0.f;
#pragma unroll
            for (int j = 0; j < 4; ++j) ss += dot4(v[j]);
            ss = wave_sum(ss);
            if (lane == 0) *(f32x4*)(rs + (size_t)m * 4) = (f32x4){ss, 0.f, 0.f, 0.f};
            u32x2* ho = (u32x2*)(XB + (size_t)m * DM) + lane;
#pragma unroll
            for (int j = 0; j < 4; ++j) { u32x2 w; w.x = pk2(v[j].x, v[j].y); w.y = pk2(v[j].z, v[j].w); ho[64 * j] = w; }
        }
#pragma unroll
        for (int j = 0; j < 4; ++j) { if (XF32) v[j] = vn[j]; else xw[j] = xwn[j]; if (HASY) yw[j] = ywn[j]; }
    }
}

typedef __bf16 bf16x2_t __attribute__((ext_vector_type(2)));
__device__ __forceinline__ float dot2bf(unsigned a, unsigned b, float c) { return __builtin_amdgcn_fdot2_f32_bf16(__builtin_bit_cast(bf16x2_t, a), __builtin_bit_cast(bf16x2_t, b), c, false); }
__device__ __forceinline__ void lru_local_item(int item, int lane, unsigned char* wl  , const bf16_t* proj,
                                               const float* cw, const float* cbias, const float* wa, const float* ba, const float* wx, const float* bx, const float* lam,
                                               unsigned* PH, float* AGG) {
    bf16_t* xc = (bf16_t*)wl;
    float* ab = (float*)(wl + 9216);
    const int b = item >> 8, c = (item >> 2) & 63, hb = item & 3;
    const int ch = hb * 64 + lane;
    const int q16 = lane & 15, g = lane >> 4;
    const size_t tok0 = (size_t)b * SEQ + (size_t)c * 64;
    const float w0 = cw[ch], w1 = cw[256 + ch], w2 = cw[512 + ch], w3 = cw[768 + ch], cb = cbias[ch];
    const bf16_t* xp = proj + tok0 * NP + ch;
    float xm3 = 0.f, xm2 = 0.f, xm1 = 0.f;
    if (c > 0) { xm3 = bf1(xp[-3 * NP]); xm2 = bf1(xp[-2 * NP]); xm1 = bf1(xp[-1 * NP]); }
    bf16_t xin[64];
#pragma unroll
    for (int t = 0; t < 64; ++t) xin[t] = xp[(size_t)t * NP];
    bf16x8 Wa[4][2], Wx[4][2];
    {
        const float* wap = wa + hb * 4096 + (8 * g) * 64 + q16; const float* wxp = wx + hb * 4096 + (8 * g) * 64 + q16;
#pragma unroll
        for (int ct = 0; ct < 4; ++ct)
#pragma unroll
            for (int ks = 0; ks < 2; ++ks) {
                const float* pa = wap + ks * 32 * 64 + ct * 16; const float* px = wxp + ks * 32 * 64 + ct * 16;
                u32x4 va, vx;
                va.x = pk2(pa[0], pa[64]); va.y = pk2(pa[128], pa[192]); va.z = pk2(pa[256], pa[320]); va.w = pk2(pa[384], pa[448]);
                vx.x = pk2(px[0], px[64]); vx.y = pk2(px[128], px[192]); vx.z = pk2(px[256], px[320]); vx.w = pk2(px[384], px[448]);
                Wa[ct][ks] = __builtin_bit_cast(bf16x8, va); Wx[ct][ks] = __builtin_bit_cast(bf16x8, vx);
            }
    }
    float bav[4], bxv[4], sp8[4];
#pragma unroll
    for (int ct = 0; ct < 4; ++ct) { const int cc = hb * 64 + ct * 16 + q16; bav[ct] = ba[cc]; bxv[ct] = bx[cc]; sp8[ct] = -8.f * log1pf(__expf(-lam[cc])); }
#pragma unroll
    for (int t = 0; t < 64; ++t) {
        const float x0 = bf1(xin[t]);
        const float v = cb + w0 * xm3 + w1 * xm2 + w2 * xm1 + w3 * x0;
        xc[t * 72 + lane] = (bf16_t)(pk2(v, v) & 0xffffu);
        xm3 = xm2; xm2 = xm1; xm1 = x0;
    }
    float h = 0.f, P = 1.f;
    unsigned* php = PH + tok0 * 256 + ch;
#pragma unroll 1
    for (int T = 0; T < 4; ++T) {
        const bf16_t* arow = xc + (T * 16 + q16) * 72 + 8 * g;
        const bf16x8 A0 = *(const bf16x8*)arow, A1 = *(const bf16x8*)(arow + 32);
#pragma unroll
        for (int ct = 0; ct < 4; ++ct) {
            f32x4 r = (f32x4){0.f, 0.f, 0.f, 0.f}, ii = (f32x4){0.f, 0.f, 0.f, 0.f};
            r = __builtin_amdgcn_mfma_f32_16x16x32_bf16(A0, Wa[ct][0], r, 0, 0, 0); r = __builtin_amdgcn_mfma_f32_16x16x32_bf16(A1, Wa[ct][1], r, 0, 0, 0);
            ii = __builtin_amdgcn_mfma_f32_16x16x32_bf16(A0, Wx[ct][0], ii, 0, 0, 0); ii = __builtin_amdgcn_mfma_f32_16x16x32_bf16(A1, Wx[ct][1], ii, 0, 0, 0);
#pragma unroll
            for (int e = 0; e < 4; ++e) {
                const int tl = 4 * g + e;
                const float xcv = bf1(xc[(T * 16 + tl) * 72 + ct * 16 + q16]);
                const float rr = sigmoidf_(r[e] + bav[ct]), ig = sigmoidf_(ii[e] + bxv[ct]);
                const float av = __expf(sp8[ct] * rr);
                const float bv = sqrtf(fmaxf(1.f - av * av, 0.f)) * ig * xcv;
                *(float2*)(ab + (tl * 64 + ct * 16 + q16) * 2) = make_float2(av, bv);
            }
        }
#pragma unroll 4
        for (int t = 0; t < 16; ++t) {
            const float2 v = *(const float2*)(ab + (t * 64 + lane) * 2);
            h = v.x * h + v.y; P *= v.x;
            php[(size_t)(T * 16 + t) * 256] = pk2(P, h);
        }
    }
    float* ag = AGG + ((size_t)(b * 64 + c) * 256 + ch) * 2;
    ag[0] = P; ag[1] = h;
}

__device__ __forceinline__ void attn_item(int item, unsigned char* smem, int tid, int lane, int wave, const bf16_t* proj, const float* sinks, bf16_t* ymix) {
    const int b = item >> 6, kvh = (item >> 5) & 1, qb = item & 31;
    bf16_t* Ks = (bf16_t*)smem;
    bf16_t* Vt = (bf16_t*)(smem + 36864);
    const long tokb = (long)b * SEQ + (long)(qb - 1) * 128;
#pragma unroll
    for (int i = 0; i < 4; ++i) {
        const int p = tid + 512 * i; const int row = p >> 3, c8 = p & 7;
        u32x4 kv = (u32x4){0u, 0u, 0u, 0u}, vv = (u32x4){0u, 0u, 0u, 0u};
        if (qb > 0 || row >= 128) {
            const bf16_t* src = proj + (tokb + row) * NP;
            kv = *(const u32x4*)(src + OFF_K + kvh * 64 + c8 * 8);
            vv = *(const u32x4*)(src + OFF_V + kvh * 64 + c8 * 8);
        }
        *(u32x4*)(Ks + row * 72 + c8 * 8) = kv;
        bf16_t* vd = Vt + (c8 * 8) * 264 + row;
        vd[0 * 264] = (bf16_t)(vv.x & 0xffffu); vd[1 * 264] = (bf16_t)(vv.x >> 16);
        vd[2 * 264] = (bf16_t)(vv.y & 0xffffu); vd[3 * 264] = (bf16_t)(vv.y >> 16);
        vd[4 * 264] = (bf16_t)(vv.z & 0xffffu); vd[5 * 264] = (bf16_t)(vv.z >> 16);
        vd[6 * 264] = (bf16_t)(vv.w & 0xffffu); vd[7 * 264] = (bf16_t)(vv.w >> 16);
    }
    __syncthreads();
    const int hq = kvh * 4 + (wave & 3), half = wave >> 2, kstart = half * 64;
    const int q16 = lane & 15, g = lane >> 4;
    const float sink = sinks[hq];
    bf16x8 qn0, qn1;
    { const bf16_t* qp = proj + ((size_t)b * SEQ + (size_t)qb * 128 + half * 64 + q16) * NP + OFF_Q + hq * 64 + 8 * g; qn0 = *(const bf16x8*)qp; qn1 = *(const bf16x8*)(qp + 32); }
#pragma unroll 1
    for (int qt = 0; qt < 4; ++qt) {
        const int qloc = half * 64 + qt * 16 + q16;
        const int qband = 128 + qloc;
        const size_t qtok = (size_t)b * SEQ + (size_t)qb * 128 + qloc;
        const bf16x8 qf0 = qn0, qf1 = qn1;
        { const int qtn = qt < 3 ? qt + 1 : qt;
          const bf16_t* qp = proj + ((size_t)b * SEQ + (size_t)qb * 128 + half * 64 + qtn * 16 + q16) * NP + OFF_Q + hq * 64 + 8 * g; qn0 = *(const bf16x8*)qp; qn1 = *(const bf16x8*)(qp + 32); }
        f32x4 s[9];
        const int kt0 = kstart + qt * 16;
#pragma unroll
        for (int j = 0; j < 9; ++j) {
            const bf16_t* kp = Ks + (kt0 + j * 16 + q16) * 72 + 8 * g;
            const bf16x8 k0 = *(const bf16x8*)kp, k1 = *(const bf16x8*)(kp + 32);
            f32x4 a = (f32x4){0.f, 0.f, 0.f, 0.f};
            a = __builtin_amdgcn_mfma_f32_16x16x32_bf16(k0, qf0, a, 0, 0, 0);
            a = __builtin_amdgcn_mfma_f32_16x16x32_bf16(k1, qf1, a, 0, 0, 0);
            s[j] = a;
        }
        float m = -1e30f;
#pragma unroll
        for (int j = 0; j < 9; ++j) {
            const bool dead = (qb == 0) && (kt0 + j * 16 < 128);
#pragma unroll
            for (int e = 0; e < 4; ++e) {
                float v = dead ? -1e30f : s[j][e] * 0.125f;
                if (j == 0) v = (4 * g + e > q16) ? v : -1e30f;
                if (j == 8) v = (4 * g + e <= q16) ? v : -1e30f;
                s[j][e] = v; m = fmaxf(m, v);
            }
        }
        m = fmaxf(m, __shfl_xor(m, 16)); m = fmaxf(m, __shfl_xor(m, 32)); m = fmaxf(m, sink);
        float sum = 0.f;
#pragma unroll
        for (int j = 0; j < 9; ++j)
#pragma unroll
            for (int e = 0; e < 4; ++e) { const float p = __expf(s[j][e] - m); s[j][e] = p; sum += p; }
        sum += __shfl_xor(sum, 16); sum += __shfl_xor(sum, 32);
        const float inv = 1.f / (sum + __expf(sink - m));
        bf16x8 pf[5];
#pragma unroll
        for (int kk = 0; kk < 4; ++kk) {
            u32x4 w; w.x = pk2(s[2 * kk][0], s[2 * kk][1]); w.y = pk2(s[2 * kk][2], s[2 * kk][3]); w.z = pk2(s[2 * kk + 1][0], s[2 * kk + 1][1]); w.w = pk2(s[2 * kk + 1][2], s[2 * kk + 1][3]);
            pf[kk] = __builtin_bit_cast(bf16x8, w);
        }
        { u32x4 w; w.x = pk2(s[8][0], s[8][1]); w.y = pk2(s[8][2], s[8][3]); w.z = 0u; w.w = 0u; pf[4] = __builtin_bit_cast(bf16x8, w); }
        bf16_t* op = ymix + qtok * DM + 256 + hq * 64 + 4 * g;
#pragma unroll
        for (int dt = 0; dt < 4; ++dt) {
            f32x4 o = (f32x4){0.f, 0.f, 0.f, 0.f};
#pragma unroll
            for (int kk = 0; kk < 5; ++kk) {
                const bf16_t* vp = Vt + (dt * 16 + q16) * 264 + kt0 + kk * 32 + 4 * g;
                const u32x2 lo = *(const u32x2*)vp, hi = (kk < 4) ? *(const u32x2*)(vp + 16) : lo;
                const u32x4 vw = (u32x4){lo.x, lo.y, hi.x, hi.y};
                o = __builtin_amdgcn_mfma_f32_16x16x32_bf16(__builtin_bit_cast(bf16x8, vw), pf[kk], o, 0, 0, 0);
            }
            u32x2 w; w.x = pk2(o[0] * inv, o[1] * inv); w.y = pk2(o[2] * inv, o[3] * inv);
            *(u32x2*)(op + dt * 16) = w;
        }
    }
    __syncthreads();
}

__device__ __forceinline__ void conf_phase(int bx, int G, unsigned char* smem, int tid, int lane, int wave, const bf16_t* proj,
                                           const float* cw, const float* cbias, const float* lng, const float* lnb, const float* gg, bf16_t* ymix) {
    constexpr int NITEM = NB * 128;
    float* st = (float*)smem;
    float* ot = (float*)(smem + 63488);
    const int ch = tid & 255, th = tid >> 8;
    float w[31];
#pragma unroll
    for (int k = 0; k < 31; ++k) w[k] = cw[k * 256 + ch];
    const float bias = cbias[ch];
    const f32x4 lg = ((const f32x4*)lng)[lane], lb = ((const f32x4*)lnb)[lane], ggv = ((const f32x4*)gg)[lane];
    u32x4 rav[4], rgv[4];
#define CONF_FETCH(item) do { const int b_ = (item) >> 7, t0_ = ((item) & 127) * 32; _Pragma("unroll") for (int i = 0; i < 4; ++i) { const int p = tid + 512 * i; const int row = p >> 5, c8 = p & 31; const int t = t0_ - 30 + row; \
        rav[i] = (u32x4){0u, 0u, 0u, 0u}; rgv[i] = (u32x4){0u, 0u, 0u, 0u}; \
        if (p < 62 * 32 && t >= 0) { const bf16_t* src = proj + ((size_t)b_ * SEQ + t) * NP + OFF_GLU + c8 * 8; rav[i] = *(const u32x4*)src; rgv[i] = *(const u32x4*)(src + 256); } } } while (0)
    if (bx < NITEM) CONF_FETCH(bx);
    for (int item = bx; item < NITEM; item += G) {
        const int b = item >> 7, t0 = (item & 127) * 32;
#pragma unroll
        for (int i = 0; i < 4; ++i) {
            const int p = tid + 512 * i; const int row = p >> 5, c8 = p & 31;
            if (p < 62 * 32) {
                const u32x4 av = rav[i], gv = rgv[i];
                f32x4 y0, y1;
                y0.x = bflo(av.x) * sigmoidf_(bflo(gv.x)); y0.y = bfhi(av.x) * sigmoidf_(bfhi(gv.x));
                y0.z = bflo(av.y) * sigmoidf_(bflo(gv.y)); y0.w = bfhi(av.y) * sigmoidf_(bfhi(gv.y));
                y1.x = bflo(av.z) * sigmoidf_(bflo(gv.z)); y1.y = bfhi(av.z) * sigmoidf_(bfhi(gv.z));
                y1.z = bflo(av.w) * sigmoidf_(bflo(gv.w)); y1.w = bfhi(av.w) * sigmoidf_(bfhi(gv.w));
                *(f32x4*)(st + row * 256 + c8 * 8) = y0; *(f32x4*)(st + row * 256 + c8 * 8 + 4) = y1;
            }
        }
        __syncthreads();
        if (item + G < NITEM) CONF_FETCH(item + G);
#pragma unroll 1
        for (int gi = 0; gi < 2; ++gi) {
            const int tau0 = th * 16 + gi * 8;
            float in[38];
#pragma unroll
            for (int i = 0; i < 38; ++i) in[i] = st[(tau0 + i) * 256 + ch];
#pragma unroll
            for (int o = 0; o < 8; ++o) { float acc = bias;
#pragma unroll
                for (int k = 0; k < 31; ++k) acc += w[k] * in[o + k];
                ot[(tau0 + o) * 256 + ch] = acc; }
        }
        __syncthreads();
#pragma unroll 2
        for (int i = 0; i < 4; ++i) {
            const int tau = wave * 4 + i;
            const f32x4 v = *(const f32x4*)(ot + tau * 256 + 4 * lane);
            const float mu = wave_sum((v.x + v.y) + (v.z + v.w)) * (1.f / 256.f);
            const f32x4 d = v - mu;
            const float rstd = rsqrtf(wave_sum(dot4(d)) * (1.f / 256.f) + LN_EPS);
            f32x4 y = d * rstd * lg + lb;
            y.x *= sigmoidf_(y.x); y.y *= sigmoidf_(y.y); y.z *= sigmoidf_(y.z); y.w *= sigmoidf_(y.w);
            const float r = rsqrtf(wave_sum(dot4(y)) * (1.f / 256.f) + NORM_EPS);
            const f32x4 o = y * r * ggv;
            u32x2 wv; wv.x = pk2(o.x, o.y); wv.y = pk2(o.z, o.w);
            *(u32x2*)(ymix + ((size_t)b * SEQ + t0 + tau) * DM + 768 + 4 * lane) = wv;
        }
    }
#undef CONF_FETCH
    __syncthreads();
}

__device__ __forceinline__ void mix2_item(int item, unsigned char* smem, int tid, int lane, int wave, const bf16_t* proj, const unsigned* PH, const float* AGG, const float* gg, bf16_t* ymix) {
    const int b = item >> 6, c = item & 63;
    float* segA = (float*)smem;
    float* segH = (float*)(smem + 8192);
    {
        const int seg = (c + 7) >> 3; const int c0 = wave * seg; const int c1 = (c0 + seg < c) ? c0 + seg : c;
        const float* ag = AGG + ((size_t)(b * 64) * 256 + 4 * lane) * 2;
        f32x4 lo[8], hi[8];
#pragma unroll
        for (int k = 0; k < 8; ++k) { const int cc = c0 + k;
            if (cc < c1) { lo[k] = *(const f32x4*)(ag + (size_t)cc * 512); hi[k] = *(const f32x4*)(ag + (size_t)cc * 512 + 4); }
            else { lo[k] = (f32x4){1.f, 0.f, 1.f, 0.f}; hi[k] = (f32x4){1.f, 0.f, 1.f, 0.f}; } }
        f32x4 A = (f32x4){1.f, 1.f, 1.f, 1.f}, Hh = (f32x4){0.f, 0.f, 0.f, 0.f};
#pragma unroll
        for (int k = 0; k < 8; ++k) {
            Hh.x = lo[k].x * Hh.x + lo[k].y; A.x *= lo[k].x; Hh.y = lo[k].z * Hh.y + lo[k].w; A.y *= lo[k].z;
            Hh.z = hi[k].x * Hh.z + hi[k].y; A.z *= hi[k].x; Hh.w = hi[k].z * Hh.w + hi[k].w; A.w *= hi[k].z; }
        *(f32x4*)(segA + wave * 256 + 4 * lane) = A; *(f32x4*)(segH + wave * 256 + 4 * lane) = Hh;
    }
    __syncthreads();
    f32x4 cr4 = (f32x4){0.f, 0.f, 0.f, 0.f};
#pragma unroll
    for (int sgi = 0; sgi < 8; ++sgi) { const f32x4 a = *(const f32x4*)(segA + sgi * 256 + 4 * lane), hh = *(const f32x4*)(segH + sgi * 256 + 4 * lane); cr4 = a * cr4 + hh; }
    const f32x4 ga = ((const f32x4*)gg)[lane];
    const f32x4 gb0 = ((const f32x4*)(gg + 256))[2 * lane], gb1 = ((const f32x4*)(gg + 256))[2 * lane + 1];
    const size_t tokb = (size_t)b * SEQ + (size_t)c * 64 + wave * 8;
    u32x4 phv[8], ovv[8]; u32x2 gtv[8];
#pragma unroll
    for (int i = 0; i < 8; ++i) {
        phv[i] = *(const u32x4*)(PH + (tokb + i) * 256 + 4 * lane);
        gtv[i] = *(const u32x2*)(proj + (tokb + i) * NP + OFF_GATE + 4 * lane);
        ovv[i] = *(const u32x4*)(ymix + (tokb + i) * DM + 256 + 8 * lane);
    }
#pragma unroll
    for (int i = 0; i < 8; ++i) {
        const u32x4 ph = phv[i]; const u32x2 gt = gtv[i]; const u32x4 ov = ovv[i];
        f32x4 ya;
        ya.x = gelu_tanh(bflo(gt.x)) * (bfhi(ph.x) + bflo(ph.x) * cr4.x);
        ya.y = gelu_tanh(bfhi(gt.x)) * (bfhi(ph.y) + bflo(ph.y) * cr4.y);
        ya.z = gelu_tanh(bflo(gt.y)) * (bfhi(ph.z) + bflo(ph.z) * cr4.z);
        ya.w = gelu_tanh(bfhi(gt.y)) * (bfhi(ph.w) + bflo(ph.w) * cr4.w);
        const float ra = rsqrtf(wave_sum(dot4(ya)) * (1.f / 256.f) + NORM_EPS);
        const f32x4 oa = ya * ra * ga;
        u32x2 wv; wv.x = pk2(oa.x, oa.y); wv.y = pk2(oa.z, oa.w);
        bf16_t* yrow = ymix + (tokb + i) * DM;
        *(u32x2*)(yrow + 4 * lane) = wv;
        f32x4 b0 = (f32x4){bflo(ov.x), bfhi(ov.x), bflo(ov.y), bfhi(ov.y)}, b1 = (f32x4){bflo(ov.z), bfhi(ov.z), bflo(ov.w), bfhi(ov.w)};
        const float rb = rsqrtf(wave_sum(dot4(b0) + dot4(b1)) * (1.f / 512.f) + NORM_EPS);
        b0 = b0 * rb * gb0; b1 = b1 * rb * gb1;
        u32x4 ow; ow.x = pk2(b0.x, b0.y); ow.y = pk2(b0.z, b0.w); ow.z = pk2(b1.x, b1.y); ow.w = pk2(b1.z, b1.w);
        *(u32x4*)(yrow + 256 + 8 * lane) = ow;
    }
    __syncthreads();
}


#define XB_TMO      128
#define XB_XCNT(j)  (256  + 64 * (j))
#define XB_XSUB(j)  (1280 + 64 * (j))
#define XB_XGEN(j)  (2304 + 64 * (j))
#define XB_TOP      3328
#define XB_TOPGEN   3392
#define XCD_BAR_WORDS 3456
#define XB_SPIN_CAP (1u << 18)
__device__ __forceinline__ unsigned xb_ld(unsigned* p)              { return __hip_atomic_load(p, __ATOMIC_RELAXED, __HIP_MEMORY_SCOPE_AGENT); }
__device__ __forceinline__ unsigned xb_add(unsigned* p, unsigned v) { return __hip_atomic_fetch_add(p, v, __ATOMIC_RELAXED, __HIP_MEMORY_SCOPE_AGENT); }
__device__ __forceinline__ unsigned xb_xcc_id() { return (unsigned)__builtin_amdgcn_s_getreg((3 << 11) | 20) & 0xFu; }
#define XB_SPIN(cond, bar) do { unsigned _sp = 0; while (cond) { __builtin_amdgcn_s_sleep(1); \
    if ((++_sp & 255u) == 0u) { if (xb_ld(&(bar)[XB_TMO])) break; if (_sp > XB_SPIN_CAP) { atomicAdd(&(bar)[XB_TMO], 1u); break; } } } } while (0)
struct XcdBarrier { unsigned* bar; unsigned x; volatile LAS unsigned* st; };
__device__ __forceinline__ void xcd_barrier_complete(unsigned* bar, unsigned x, unsigned& nloc, unsigned& nx) {
    const unsigned G = gridDim.x * gridDim.y * gridDim.z;
    unsigned sum, cnt, mine, sp = 0u;
    for (;;) {
        sum = 0u; cnt = 0u; mine = 0u;
#pragma unroll
        for (unsigned j = 0; j < 16; ++j) { const unsigned c = xb_ld(&bar[XB_XCNT(j)]); sum += c; cnt += (c > 0u) ? 1u : 0u; mine = (j == x) ? c : mine; }
        if (sum == G) break;
        __builtin_amdgcn_s_sleep(1);
        if ((++sp & 255u) == 0u) { if (xb_ld(&bar[XB_TMO])) break; if (sp > XB_SPIN_CAP) { atomicAdd(&bar[XB_TMO], 1u); break; } }
    }
    nloc = mine > 0u ? mine : 1u; nx = cnt > 0u ? cnt : 1u;
}
__device__ __forceinline__ void xcd_barrier(const XcdBarrier& b) {
    asm volatile("s_waitcnt vmcnt(0)" ::: "memory");
    __syncthreads();
    if (threadIdx.x == 0) {
        unsigned* bar = b.bar;
        __builtin_amdgcn_s_waitcnt(0);
        unsigned nloc = b.st[0], nx = b.st[1];
        if (nloc == 0u) { xcd_barrier_complete(bar, b.x, nloc, nx); b.st[0] = nloc; b.st[1] = nx; }
        const unsigned old = xb_add(&bar[XB_XSUB(b.x)], 1u);
        const unsigned gen = old / nloc;
        if (old + 1u == (gen + 1u) * nloc) {
            __builtin_amdgcn_fence(__ATOMIC_RELEASE, "agent");
            asm volatile("s_waitcnt vmcnt(0)" ::: "memory");
            const unsigned og = xb_add(&bar[XB_TOP], 1u);
            const unsigned tg = og / nx;
            if (og + 1u == (tg + 1u) * nx) xb_add(&bar[XB_TOPGEN], 1u);
            else XB_SPIN(xb_ld(&bar[XB_TOPGEN]) == tg, bar);
            __builtin_amdgcn_fence(__ATOMIC_ACQUIRE, "agent");
            xb_add(&bar[XB_XGEN(b.x)], 1u);
            asm volatile("s_waitcnt vmcnt(0)" ::: "memory");
        } else {
            XB_SPIN(xb_ld(&bar[XB_XGEN(b.x)]) == gen, bar);
            __builtin_amdgcn_fence(__ATOMIC_ACQUIRE, "agent");
            asm volatile("s_waitcnt vmcnt(0)" ::: "memory");
        }
    }
    __syncthreads();
}
constexpr int MISC_OFF = 147456 - 16;

struct Args { const float* in[26]; float* out; unsigned char* ws; };

__device__ __forceinline__ const Args* args_ptr() {
    const Args* ap = (const Args*)__builtin_amdgcn_kernarg_segment_ptr();
    asm volatile("" : "+s"(ap));
    return ap;
}
#define GAS __attribute__((address_space(1)))
struct ArgsG { GAS const float* in[26]; GAS float* out; GAS unsigned char* ws; };
#define WSP(off) ((unsigned char*)(((const ArgsG*)ap)->ws + (off)))
#define AIN(k) ((const float*)(((const ArgsG*)ap)->in[k]))
#define AOUT ((float*)(((const ArgsG*)ap)->out))

#ifndef REP_GEMM
#define REP_GEMM 1
#endif
#ifndef REP_SYNC
#define REP_SYNC 1
#endif
#ifndef REP_MIX
#define REP_MIX 1
#endif
#ifndef REP_NORM
#define REP_NORM 1
#endif
#ifndef REP_P0
#define REP_P0 1
#endif
#define GSYNC() do { _Pragma("nounroll") for (int r_ = 0; r_ < REP_SYNC; ++r_) { const Args* ap_ = args_ptr(); XcdBarrier b_; b_.bar = (unsigned*)(((const ArgsG*)ap_)->ws); b_.x = xb_xcc_id(); b_.st = (volatile LAS unsigned*)(ldsl + MISC_OFF); xcd_barrier(b_); } } while (0)
#define TID_VARS int tid_ = threadIdx.x; asm volatile("" : "+v"(tid_)); const int tid = tid_, lane = tid & 63, wave = __builtin_amdgcn_readfirstlane(tid >> 6); int G_ = gridDim.x, bx_ = blockIdx.x; asm volatile("" : "+s"(G_), "+s"(bx_)); const int G = G_, bx = bx_; const int gw = bx * NWAVES + wave, NGW = G * NWAVES; (void)lane; (void)gw; (void)NGW; (void)tid
#define GEMM_PHASE(EPI, AOFF, WOFF, NN, KK, OOFF, LDC, RSP) do { _Pragma("nounroll") for (int r_ = 0; r_ < REP_GEMM; ++r_) { const Args* ap = args_ptr(); \
        pg8::Gemm g{(const bf16_t*)WSP(AOFF), (const bf16_t*)WSP(WS_W + (size_t)l * W_LAYER + (WOFF)), TOK, NN, KK}; pg8::StaticOrderRS S; S.init(TOK, NN, (int)gridDim.x, (int)blockIdx.x); S.ssp = RSP; S.tab = ldsl + RSTAB_OFF; \
        pg8::EPI E{(bf16_t*)WSP(OOFF), LDC, ldsl + RSTAB_OFF}; pg8::gemm_phase<pg8::EPI, pg8::StaticOrderRS, true, true>(ldsl, g, S, E); } } while (0)
namespace pg8 {
template <bool FINAL, int GIN, int GOFF, int SCALE2, int BANK> struct EpiNormRes {
    static constexpr bool PERM = true, AFTER_DRAIN = false;
    __device__ __forceinline__ void operator()(const f32x4 (&acc)[2][2][4][2], const Unit& u, int wr_, int wc_, int fr_, int fq_) const {
        int wr = wr_, wc = wc_, fr = fr_, fq = fq_; asm volatile("" : "+s"(wr), "+s"(wc), "+v"(fr), "+v"(fq));
        const Args* ap = args_ptr();
        bf16_t* XB = (bf16_t*)WSP(WS_H); float* out = AOUT; const float* g = AIN(GIN) + GOFF; const float scale = 0.5f * SCALE2;
        unsigned long long* slots = (unsigned long long*)WSP(WS_SLOTS + (size_t)BANK * SLOT_BANK); float* ssp = (float*)WSP(WS_RS);
        PG8_LAS unsigned char* xl = (PG8_LAS unsigned char*)(XL_OFF);
        PG8_LAS float* P = (PG8_LAS float*)xl;
        PG8_LAS float* Sx = (PG8_LAS float*)(xl + 4096);
        const int lane = fr + 16 * fq, wid = wr * 4 + wc;
#pragma unroll
        for (int ai = 0; ai < 2; ++ai)
#pragma unroll
            for (int m = 0; m < 4; ++m) {
                float sq = 0.f;
#pragma unroll
                for (int bj = 0; bj < 2; ++bj)
#pragma unroll
                    for (int n = 0; n < 2; ++n) { const f32x4 x = acc[ai][bj][m][n]; sq += (x[0] * x[0] + x[1] * x[1]) + (x[2] * x[2] + x[3] * x[3]); }
                sq += __shfl_xor(sq, 16); sq += __shfl_xor(sq, 32);
                if (fq == 0) P[(ai * HALF + wr * 64 + m * 16 + fr) * 4 + wc] = sq;
            }
        asm volatile("s_waitcnt lgkmcnt(0)" ::: "memory"); __builtin_amdgcn_s_barrier(); asm volatile("" ::: "memory");
        const int col0 = u.pn * BM + wc * 32 + 8 * fq;
        f32x4 gv[2][2];
#pragma unroll
        for (int bj = 0; bj < 2; ++bj)
#pragma unroll
            for (int n = 0; n < 2; ++n) gv[bj][n] = *(const f32x4*)(g + col0 + bj * HALF + 4 * n);
        u32x4 xpre[4][2];
#pragma unroll
        for (int m = 0; m < 4; ++m)
#pragma unroll
            for (int bj = 0; bj < 2; ++bj) xpre[m][bj] = *(const u32x4*)(XB + (size_t)(u.pm * BM + wr * 64 + m * 16 + fr) * 1024 + col0 + bj * HALF);
        if (lane < 32) {
            const int row = wid * 32 + lane;
            const f32x4 p = *(const PG8_LAS f32x4*)(P + row * 4);
            unsigned long long* sl = slots + (size_t)(u.pm * BM + row) * 4;
            __hip_atomic_store(sl + u.pn, (1ull << 32) | (unsigned long long)__float_as_uint((p[0] + p[1]) + (p[2] + p[3])), __ATOMIC_RELAXED, __HIP_MEMORY_SCOPE_AGENT);
            unsigned long long w0, w1, w2, w3; unsigned sp = 0u;
            for (;;) {
                w0 = __hip_atomic_load(sl + 0, __ATOMIC_RELAXED, __HIP_MEMORY_SCOPE_AGENT); w1 = __hip_atomic_load(sl + 1, __ATOMIC_RELAXED, __HIP_MEMORY_SCOPE_AGENT);
                w2 = __hip_atomic_load(sl + 2, __ATOMIC_RELAXED, __HIP_MEMORY_SCOPE_AGENT); w3 = __hip_atomic_load(sl + 3, __ATOMIC_RELAXED, __HIP_MEMORY_SCOPE_AGENT);
                if ((((w0 >> 32) & (w1 >> 32)) & ((w2 >> 32) & (w3 >> 32))) != 0ull) break;
                __builtin_amdgcn_s_sleep(1); if (++sp > (1u << 20)) break;
            }
            const float t = (__uint_as_float((unsigned)w0) + __uint_as_float((unsigned)w1)) + (__uint_as_float((unsigned)w2) + __uint_as_float((unsigned)w3));
            Sx[row] = scale * rsqrtf(t * (1.f / 1024.f) + 1e-6f);
        }
        asm volatile("s_waitcnt vmcnt(0) lgkmcnt(0)" ::: "memory"); __builtin_amdgcn_s_barrier(); asm volatile("" ::: "memory");
#pragma unroll
        for (int ai = 0; ai < 2; ++ai)
#pragma unroll
            for (int m = 0; m < 4; ++m) {
                const int rl = ai * HALF + wr * 64 + m * 16 + fr; const size_t grow = (size_t)(u.pm * BM + rl);
                const float c = Sx[rl]; float sq = 0.f;
#pragma unroll
                for (int bj = 0; bj < 2; ++bj) {
                    bf16_t* xp = XB + grow * 1024 + col0 + bj * HALF;
                    const u32x4 xw = (ai == 0) ? xpre[m][bj] : *(const u32x4*)xp;
                    const f32x4 x0 = (f32x4){__uint_as_float(xw.x << 16), __uint_as_float(xw.x & 0xffff0000u), __uint_as_float(xw.y << 16), __uint_as_float(xw.y & 0xffff0000u)};
                    const f32x4 x1 = (f32x4){__uint_as_float(xw.z << 16), __uint_as_float(xw.z & 0xffff0000u), __uint_as_float(xw.w << 16), __uint_as_float(xw.w & 0xffff0000u)};
                    const f32x4 v0 = x0 + acc[ai][bj][m][0] * c * gv[bj][0], v1 = x1 + acc[ai][bj][m][1] * c * gv[bj][1];
                    if (FINAL) { float* op = out + grow * 1024 + col0 + bj * HALF; __builtin_nontemporal_store(v0, (f32x4*)op); __builtin_nontemporal_store(v1, (f32x4*)(op + 4)); }
                    else { sq += ((v0[0] * v0[0] + v0[1] * v0[1]) + (v0[2] * v0[2] + v0[3] * v0[3])) + ((v1[0] * v1[0] + v1[1] * v1[1]) + (v1[2] * v1[2] + v1[3] * v1[3]));
                        u32x4 w; w.x = cvt_pk_bf16(v0[0], v0[1]); w.y = cvt_pk_bf16(v0[2], v0[3]); w.z = cvt_pk_bf16(v1[0], v1[1]); w.w = cvt_pk_bf16(v1[2], v1[3]); *(u32x4*)xp = w; }
                }
                if (!FINAL) { sq += __shfl_xor(sq, 16); sq += __shfl_xor(sq, 32); if (fq == 0) P[rl * 4 + wc] = sq; }
            }
        if (!FINAL) {
            asm volatile("s_waitcnt lgkmcnt(0)" ::: "memory"); __builtin_amdgcn_s_barrier(); asm volatile("" ::: "memory");
            if (lane < 32) { const int row = wid * 32 + lane; const f32x4 p = *(const PG8_LAS f32x4*)(P + row * 4); ssp[(size_t)(u.pm * BM + row) * 4 + u.pn] = (p[0] + p[1]) + (p[2] + p[3]); }
        }
    }
};

}

#define GEMM_FUSED(FINAL, AOFF, WOFF, KK, GIN, GOFF, SCALE2, BANK) do { const Args* ap = args_ptr(); \
        pg8::Gemm g{(const bf16_t*)WSP(AOFF), (const bf16_t*)WSP(WS_W + (size_t)l * W_LAYER + (WOFF)), TOK, DM, KK}; pg8::StaticOrder S; S.init(TOK, DM, (int)gridDim.x, (int)blockIdx.x); \
        typedef pg8::EpiNormRes<FINAL, GIN, GOFF, SCALE2, BANK> EpiT; EpiT E; \
        pg8::gemm_phase<EpiT, pg8::StaticOrder, true, true>(ldsl, g, S, E); } while (0)
template <int l> __device__ __forceinline__ void layer_body(unsigned char* lds, LAS unsigned char* ldsl, cg::grid_group& grid) {
        GEMM_PHASE(EpiSwiGLU, WS_H, WO_GU1, 2 * FF, DM, WS_ACT, FF, (const float*)WSP(WS_RS));
        GSYNC();
        GEMM_FUSED(false, WS_ACT, WO_DOWN1, FF, 4, l * DM, 1, 3 * l + 0);
        GSYNC();
        GEMM_PHASE(EpiBf16S, WS_H, WO_IN, NP, DM, WS_PROJ, NP, (const float*)WSP(WS_RS));
        GSYNC();
        _Pragma("nounroll") for (int rm_ = 0; rm_ < REP_MIX; ++rm_) {
#ifndef SKIP_LRU
            { TID_VARS; const Args* ap = args_ptr();
              for (int it = gw; it < NB * 64 * 4; it += NGW)
                lru_local_item(it, lane, lds + wave * 17408, (const bf16_t*)WSP(WS_PROJ), AIN(7) + l * 4 * 256, AIN(8) + l * 256, AIN(9) + l * 16384, AIN(10) + l * 256,
                               AIN(11) + l * 16384, AIN(12) + l * 256, AIN(13) + l * 256, (unsigned*)WSP(WS_PH), (float*)WSP(WS_AGG)); }
#endif
            __syncthreads();
#ifndef SKIP_ATTN
            { TID_VARS; const Args* ap = args_ptr();
              for (int it = bx; it < NB * 2 * 32; it += G) attn_item(it, lds, tid, lane, wave, (const bf16_t*)WSP(WS_PROJ), AIN(14) + l * 8, (bf16_t*)WSP(WS_YMIX)); }
#endif
#ifndef SKIP_CONF
            { TID_VARS; const Args* ap = args_ptr();
              conf_phase(bx, G, lds, tid, lane, wave, (const bf16_t*)WSP(WS_PROJ), AIN(15) + l * 31 * 256, AIN(16) + l * 256, AIN(17) + l * 256, AIN(18) + l * 256, AIN(19) + l * 1024 + 768, (bf16_t*)WSP(WS_YMIX)); }
#endif
        }
        GSYNC();
#ifndef SKIP_MIX2
        { TID_VARS; const Args* ap = args_ptr();
          for (int it = bx; it < NB * 64; it += G) mix2_item(it, lds, tid, lane, wave, (const bf16_t*)WSP(WS_PROJ), (const unsigned*)WSP(WS_PH), (const float*)WSP(WS_AGG), AIN(19) + l * 1024, (bf16_t*)WSP(WS_YMIX)); }
#endif
        GSYNC();
        GEMM_FUSED(false, WS_YMIX, WO_OUT, DM, 21, l * DM, 2, 3 * l + 1);
        GSYNC();
        GEMM_PHASE(EpiSwiGLU, WS_H, WO_GU2, 2 * FF, DM, WS_ACT, FF, (const float*)WSP(WS_RS));
        GSYNC();
        if (l == 0) { GEMM_FUSED(false, WS_ACT, WO_DOWN2, FF, 25, 0, 1, 3 * l + 2); GSYNC(); }
        else GEMM_FUSED(true, WS_ACT, WO_DOWN2, FF, 25, DM, 1, 3 * l + 2);
}

__global__ void __launch_bounds__(NWAVES * 64, 2) hymba_fwd(Args args_unused) {
    extern __shared__ __attribute__((aligned(16))) unsigned char lds[];
    cg::grid_group grid = cg::this_grid();
    LAS unsigned char* ldsl = (LAS unsigned char*)lds;
    if (threadIdx.x < 2) ((volatile LAS unsigned*)(ldsl + MISC_OFF))[threadIdx.x] = 0u;
    if (blockIdx.x == 0) { const Args* ap = args_ptr(); for (int i = threadIdx.x; i < XCD_BAR_WORDS; i += NWAVES * 64) ((unsigned*)WSP(0))[i] = 0u; }
    { const Args* ap = args_ptr(); u32x4* cz = (u32x4*)WSP(WS_SLOTS); for (int i = blockIdx.x * (NWAVES * 64) + threadIdx.x; i < (int)(6 * SLOT_BANK / 16); i += gridDim.x * NWAVES * 64) cz[i] = (u32x4){0u, 0u, 0u, 0u}; }
    __syncthreads();

    _Pragma("nounroll") for (int rp_ = 0; rp_ < REP_P0; ++rp_) {
        TID_VARS; const Args* ap = args_ptr();
        constexpr int I_GU = (DM / 64) * (2 * FF / 64), I_DOWN = (FF / 64) * (DM / 64), I_IN = (DM / 64) * (NP / 64), I_OUT = (DM / 64) * (DM / 64);
        constexpr int I_LAYER = 2 * I_GU + 2 * I_DOWN + I_IN + I_OUT;
        for (int it = gw; it < 2 * I_LAYER; it += NGW) {
            const int l = it / I_LAYER; int r = it % I_LAYER;
            unsigned char* wb = WSP(WS_W + (size_t)l * W_LAYER);
            if (r < I_GU) { transpose_item(AIN(2) + (size_t)l * DM * 2 * FF, DM, 2 * FF, (bf16_t*)(wb + WO_GU1), true, AIN(1) + l * DM, r, lane); continue; } r -= I_GU;
            if (r < I_GU) { transpose_item(AIN(23) + (size_t)l * DM * 2 * FF, DM, 2 * FF, (bf16_t*)(wb + WO_GU2), true, AIN(22) + l * DM, r, lane); continue; } r -= I_GU;
            if (r < I_DOWN) { transpose_item(AIN(3) + (size_t)l * FF * DM, FF, DM, (bf16_t*)(wb + WO_DOWN1), false, nullptr, r, lane); continue; } r -= I_DOWN;
            if (r < I_DOWN) { transpose_item(AIN(24) + (size_t)l * FF * DM, FF, DM, (bf16_t*)(wb + WO_DOWN2), false, nullptr, r, lane); continue; } r -= I_DOWN;
            if (r < I_IN) { transpose_item(AIN(6) + (size_t)l * DM * NP, DM, NP, (bf16_t*)(wb + WO_IN), false, AIN(5) + l * DM, r, lane); continue; } r -= I_IN;
            transpose_item(AIN(20) + (size_t)l * DM * DM, DM, DM, (bf16_t*)(wb + WO_OUT), false, nullptr, r, lane);
        }
        norm_phase<0>(gw, NGW, lane, AIN(0), nullptr, (bf16_t*)WSP(WS_H), nullptr, nullptr, 1.f, (float*)WSP(WS_RS));
    }
    grid.sync();
    if (threadIdx.x == 0) { const Args* ap = args_ptr(); (void)xb_add(&((unsigned*)WSP(0))[XB_XCNT(xb_xcc_id())], 1u); }

    layer_body<0>(lds, ldsl, grid);
    layer_body<1>(lds, ldsl, grid);
}

extern "C" void kernel_launch(void* const* d_in, const int* in_sizes, int n_in, void* d_out, int out_size, void* d_ws, size_t ws_size, hipStream_t stream) {
    static int grid = 0;
    if (grid == 0) {
        if (n_in != 26 || out_size != TOK * DM || ws_size < WS_END) { fprintf(stderr, "kernel_launch: unexpected shapes (n_in %d out %d ws %zu)\n", n_in, out_size, ws_size); grid = -1; return; }
        int dev = 0, cus = 0, per_cu = 0;
        hipGetDevice(&dev);
        hipDeviceGetAttribute(&cus, hipDeviceAttributeMultiprocessorCount, dev);
        hipFuncSetAttribute((const void*)hymba_fwd, hipFuncAttributeMaxDynamicSharedMemorySize, LDS_BYTES);
        hipOccupancyMaxActiveBlocksPerMultiprocessor(&per_cu, (const void*)hymba_fwd, NWAVES * 64, LDS_BYTES);
        if (per_cu < 1) { fprintf(stderr, "kernel_launch: occupancy query says %d blocks/CU\n", per_cu); per_cu = 1; }
        (void)hipGetLastError();
        grid = cus;
    }
    if (grid < 0) return;
    Args a{};
    for (int i = 0; i < 26; ++i) a.in[i] = (const float*)d_in[i];
    a.out = (float*)d_out; a.ws = (unsigned char*)d_ws;
    void* params[] = {&a};
    hipError_t e = hipLaunchCooperativeKernel((const void*)hymba_fwd, dim3(grid), dim3(NWAVES * 64), params, LDS_BYTES, stream);
    if (e != hipSuccess) fprintf(stderr, "cooperative launch failed: %s (grid %d)\n", hipGetErrorString(e), grid);
}
```

```cpp
#include <hip/hip_runtime.h>
#include <hip/hip_cooperative_groups.h>
#include <cstdio>
#include <cstdint>
namespace cg = cooperative_groups;

namespace pg8 {
#define PG8_LAS __attribute__((address_space(3)))
typedef unsigned short bf16_t;
typedef short bf16x8 __attribute__((ext_vector_type(8)));
typedef float f32x4 __attribute__((ext_vector_type(4)));
typedef unsigned u32x4 __attribute__((ext_vector_type(4)));
constexpr int BM = 256, BK = 64, HALF = 128, HTB = HALF * BK * 2, STAGE_BYTES = 8 * HTB, NXCD = 8, WGM = 8;

__host__ __device__ __forceinline__ int lds_byte(int r, int c) { const int st = (r >> 4) * 2 + (c >> 5), rr = r & 15, cc = c & 31, ob = rr * 64 + cc * 2; return st * 1024 + (ob ^ (((ob >> 9) & 1) << 5)); }
__host__ __device__ __forceinline__ void stage_rc(int b, int& R, int& C) { const int st = b / 1024, sb = b % 1024, swz = sb ^ (((sb >> 9) & 1) << 5); R = (st >> 1) * 16 + swz / 64; C = (st & 1) * 32 + (swz % 64) / 2; }
__host__ __device__ __forceinline__ int perm32(int rho) { const int n = rho >> 4, i = rho & 15; return 8 * (i >> 2) + 4 * n + (i & 3); }

struct Unit { int pm, pn, par; };
struct Gemm { const bf16_t* A; const bf16_t* Bt; int M, N, K; };

struct StaticOrder {
    int nM, nN, nwg, G, c;
    __host__ __device__ void init(int M, int N, int G_, int c_) { nM = M / BM; nN = N / BM; nwg = nM * nN; G = G_; c = c_; }
    __host__ __device__ bool next(int i, Unit& u) const {
        const long L = (long)i * G + c; if (L >= nwg) return false;
        int wgid = (int)L; { const int q = nwg / NXCD, r = nwg % NXCD, xcd = wgid % NXCD, off = wgid / NXCD; wgid = (xcd < r ? xcd * (q + 1) : r * (q + 1) + (xcd - r) * q) + off; }
        const int nig = WGM * nN, gid = wgid / nig, fm = gid * WGM, gsz = (nM - fm) < WGM ? (nM - fm) : WGM;
        u.pm = fm + ((wgid % nig) % gsz); u.pn = (wgid % nig) / gsz; u.par = i & 1; return true;
    }
    __device__ __forceinline__ void a_ready(const Unit&) const {}
    __device__ __forceinline__ void done(const Unit&) const {}
};

struct StaticOrderRS : StaticOrder {
    const float* ssp; PG8_LAS unsigned char* tab;
    __device__ __forceinline__ void a_ready(const Unit& u) const {
        const int tid = threadIdx.x; const int wid = __builtin_amdgcn_readfirstlane(tid >> 6), lane = tid & 63;
        if (wid < 4) __builtin_amdgcn_global_load_lds((const unsigned*)(ssp + ((size_t)u.pm * BM + wid * 64 + lane) * 4), (PG8_LAS unsigned*)(tab + u.par * 4096 + wid * 1024), 16, 0, 0);
    }
};

__device__ __forceinline__ unsigned cvt_pk_bf16(float lo, float hi) { unsigned r; asm volatile("v_cvt_pk_bf16_f32 %0, %1, %2" : "=v"(r) : "v"(lo), "v"(hi)); return r; }

template <bool SCALE> struct EpiBf16T {
    static constexpr bool PERM = true, AFTER_DRAIN = false;
    bf16_t* O; int ldc; PG8_LAS unsigned char* rs;
    __device__ __forceinline__ void operator()(const f32x4 (&acc)[2][2][4][2], const Unit& u, int wr, int wc, int fr, int fq) const {
        const int row0 = u.pm * BM + wr * 64 + fr; const int col0 = u.pn * BM + wc * 32 + 8 * fq;
#pragma unroll
        for (int ai = 0; ai < 2; ++ai)
#pragma unroll
            for (int m = 0; m < 4; ++m) { const int row = row0 + ai * HALF + m * 16; bf16_t* rowp = O + (size_t)row * ldc + col0;
                float sc = 1.f; if (SCALE) { const f32x4 p4 = *(const PG8_LAS f32x4*)(rs + u.par * 4096 + (wr * 64 + fr + ai * HALF + m * 16) * 16); sc = rsqrtf(((p4[0] + p4[1]) + (p4[2] + p4[3])) * (1.f / 1024.f) + 1e-6f); }
#pragma unroll
                for (int bj = 0; bj < 2; ++bj) { const f32x4 v0 = acc[ai][bj][m][0] * sc, v1 = acc[ai][bj][m][1] * sc;
                    u32x4 w; w.x = cvt_pk_bf16(v0[0], v0[1]); w.y = cvt_pk_bf16(v0[2], v0[3]); w.z = cvt_pk_bf16(v1[0], v1[1]); w.w = cvt_pk_bf16(v1[2], v1[3]);
                    *(u32x4*)(rowp + bj * HALF) = w; } }
    }
};
typedef EpiBf16T<false> EpiBf16; typedef EpiBf16T<true> EpiBf16S;
typedef float f32x2 __attribute__((ext_vector_type(2)));
__device__ __forceinline__ float silu_mul(float g, float u) { return g * u * __builtin_amdgcn_rcpf(1.f + __expf(-g)); }
struct EpiSwiGLU {
    static constexpr bool PERM = true, AFTER_DRAIN = false;
    bf16_t* O; int ldc; PG8_LAS unsigned char* rs;
    __device__ __forceinline__ void operator()(const f32x4 (&acc)[2][2][4][2], const Unit& u, int wr, int wc, int fr, int fq) const {
        const int row0 = u.pm * BM + wr * 64 + fr; const int col0 = u.pn * HALF + wc * 32 + 8 * fq;
#pragma unroll
        for (int ai = 0; ai < 2; ++ai)
#pragma unroll
            for (int m = 0; m < 4; ++m) { const int row = row0 + ai * HALF + m * 16; bf16_t* rowp = O + (size_t)row * ldc + col0;
                const f32x4 p4 = *(const PG8_LAS f32x4*)(rs + u.par * 4096 + (wr * 64 + fr + ai * HALF + m * 16) * 16); const float sc = rsqrtf(((p4[0] + p4[1]) + (p4[2] + p4[3])) * (1.f / 1024.f) + 1e-6f);
                const float kk = -1.4426950408889634f * sc, sc2 = sc * sc;
                u32x4 w; unsigned wq[4];
#pragma unroll
                for (int q = 0; q < 4; ++q) { const int n = q >> 1, e0 = (q & 1) * 2;
                    const f32x2 gg = (f32x2){acc[ai][0][m][n][e0], acc[ai][0][m][n][e0 + 1]}, uu = (f32x2){acc[ai][1][m][n][e0], acc[ai][1][m][n][e0 + 1]};
                    const f32x2 t = gg * kk; f32x2 d; d.x = __builtin_amdgcn_exp2f(t.x); d.y = __builtin_amdgcn_exp2f(t.y); d = d + 1.0f;
                    f32x2 r; r.x = __builtin_amdgcn_rcpf(d.x); r.y = __builtin_amdgcn_rcpf(d.y);
                    const f32x2 o = ((gg * uu) * sc2) * r;
                    wq[q] = cvt_pk_bf16(o.x, o.y); }
                w.x = wq[0]; w.y = wq[1]; w.z = wq[2]; w.w = wq[3];
                *(u32x4*)rowp = w; }
    }
};


template <class Epi, class Sched, bool ALIGN_EPI = false, bool SP2 = false>
__device__ __forceinline__ void gemm_phase(PG8_LAS unsigned char* lds, const Gemm g, const Sched& S, const Epi& E) {
    int tid_ = threadIdx.x; asm volatile("" : "+v"(tid_));
    const int tid = tid_, wid = __builtin_amdgcn_readfirstlane(tid >> 6), lane = tid & 63, wr = wid >> 2, wc = wid & 3, fr = lane & 15, fq = lane >> 4;
    const int K = g.K, nt = K / BK;
    unsigned voffA[2], voffB[2];
#pragma unroll
    for (int i = 0; i < 2; ++i) { int R, C; stage_rc(tid * 16 + i * 8192, R, C); const int Rb = Epi::PERM ? ((R & ~31) + perm32(R & 31)) : R;
        voffA[i] = (unsigned)(R * K + C) * 2u; voffB[i] = (unsigned)(Rb * K + C) * 2u; }
    const size_t kstep = (size_t)(BK * 2);
    const size_t hstep = (size_t)HALF * K * 2;
    const size_t tstep = 2 * hstep;
    const unsigned ldsw = (unsigned)wid * 1024u;
    const int aoff = lds_byte(wr * 64 + fr, fq * 8), boff = lds_byte(wc * 32 + fr, fq * 8);
#define PG8_SA(b, h) (((b) * 2 + (h)) * HTB)
#define PG8_SB(b, h) ((4 + (b) * 2 + (h)) * HTB)
#define PG8_STAGE(bufoff, gbase, voff) do { _Pragma("unroll") for (int _i = 0; _i < 2; ++_i) \
        __builtin_amdgcn_global_load_lds((const unsigned*)((const char*)(gbase) + (voff)[_i]), (PG8_LAS unsigned*)(lds + (bufoff) + ldsw + _i * 8192), 16, 0, 0); } while (0)
#define PG8_LDA(dst, b, h) do { _Pragma("unroll") for (int m = 0; m < 4; ++m) _Pragma("unroll") for (int k = 0; k < 2; ++k) dst[m][k] = *(const PG8_LAS bf16x8*)(lds + PG8_SA(b, h) + aoff + m * 2048 + k * 1024); } while (0)
#define PG8_LDB(dst, b, h) do { _Pragma("unroll") for (int n = 0; n < 2; ++n) _Pragma("unroll") for (int k = 0; k < 2; ++k) dst[n][k] = *(const PG8_LAS bf16x8*)(lds + PG8_SB(b, h) + boff + n * 2048 + k * 1024); } while (0)
#define PG8_MMA(ai, bj, At, Bt) do { __builtin_amdgcn_s_setprio(1); _Pragma("unroll") for (int m = 0; m < 4; ++m) _Pragma("unroll") for (int n = 0; n < 2; ++n) _Pragma("unroll") for (int k = 0; k < 2; ++k) \
        acc[ai][bj][m][n] = __builtin_amdgcn_mfma_f32_16x16x32_bf16(Bt[n][k], At[m][k], acc[ai][bj][m][n], 0, 0, 0); __builtin_amdgcn_s_setprio(0); } while (0)
#define PG8_WAIT_V(n) asm volatile("s_waitcnt vmcnt(" #n ")" ::: "memory")
#define PG8_WAIT_L(n) asm volatile("s_waitcnt lgkmcnt(" #n ")" ::: "memory")
#define PG8_BAR __builtin_amdgcn_s_barrier()
#define PG8_SCHED __builtin_amdgcn_sched_barrier(0)
    Unit cur, nxt; int ui = 0;
    if (!S.next(0, cur)) return;
    f32x4 acc[2][2][4][2];
#pragma unroll
    for (int a = 0; a < 2; ++a)
#pragma unroll
        for (int b = 0; b < 2; ++b)
#pragma unroll
            for (int m = 0; m < 4; ++m)
#pragma unroll
                for (int n = 0; n < 2; ++n) acc[a][b][m][n] = (f32x4){0.f, 0.f, 0.f, 0.f};
    bf16x8 At[4][2], B0[2][2], B1[2][2];
    const char* cA = (const char*)g.A + (size_t)cur.pm * tstep; const char* cB = (const char*)g.Bt + (size_t)cur.pn * tstep;
    S.a_ready(cur);
    if constexpr (SP2) {
        PG8_STAGE(PG8_SB(0, 0), cB, voffB); PG8_STAGE(PG8_SB(0, 1), cB + hstep, voffB); PG8_STAGE(PG8_SA(0, 0), cA, voffA); PG8_STAGE(PG8_SA(0, 1), cA + hstep, voffA);
        if (wr == 1) PG8_BAR;
        PG8_WAIT_V(2); PG8_BAR;
        PG8_STAGE(PG8_SB(1, 0), cB + kstep, voffB); PG8_STAGE(PG8_SA(1, 0), cA + kstep, voffA); PG8_STAGE(PG8_SB(1, 1), cB + hstep + kstep, voffB);
        PG8_WAIT_V(6); PG8_BAR;
    } else {
        PG8_STAGE(PG8_SB(0, 0), cB, voffB); PG8_STAGE(PG8_SA(0, 0), cA, voffA); PG8_STAGE(PG8_SB(0, 1), cB + hstep, voffB); PG8_STAGE(PG8_SA(0, 1), cA + hstep, voffA);
        if (wr == 1) PG8_BAR;
        PG8_WAIT_V(4); PG8_BAR;
        PG8_STAGE(PG8_SB(1, 0), cB + kstep, voffB); PG8_STAGE(PG8_SA(1, 0), cA + kstep, voffA); PG8_STAGE(PG8_SB(1, 1), cB + hstep + kstep, voffB);
        PG8_WAIT_V(6); PG8_BAR;
    }
    for (;;) {
        const bool has_next = S.next(ui + 1, nxt);
        const char* nA = has_next ? (const char*)g.A + (size_t)nxt.pm * tstep : cA; const char* nB = has_next ? (const char*)g.Bt + (size_t)nxt.pn * tstep : cB;
        asm volatile(".p2align 6\n\ts_nop 0\n\ts_nop 0\n\ts_nop 0\n\ts_nop 0\n\ts_nop 0\n\ts_nop 0\n\ts_nop 0\n\ts_nop 0" ::: );
        for (int t = 0; t < nt; t += 2) {
            const bool last = (t == nt - 2);
            const char* a1 = cA + (size_t)(t + 1) * kstep;
            const char* a2 = last ? nA : cA + (size_t)(t + 2) * kstep; const char* b2 = last ? nB : cB + (size_t)(t + 2) * kstep;
            const char* a3 = a2 + kstep; const char* b3 = b2 + kstep;
            if (last && has_next) S.a_ready(nxt);
            if constexpr (SP2) {
            PG8_LDB(B0, 0, 0); PG8_LDB(B1, 0, 1); PG8_SCHED; PG8_LDA(At, 0, 0); PG8_STAGE(PG8_SA(1, 1), a1 + hstep, voffA);
            PG8_WAIT_V(8); PG8_WAIT_L(0); PG8_BAR; PG8_MMA(0, 0, At, B0); PG8_MMA(0, 1, At, B1); PG8_BAR; PG8_SCHED;
            PG8_LDA(At, 0, 1); PG8_STAGE(PG8_SB(0, 0), b2, voffB); PG8_STAGE(PG8_SB(0, 1), b2 + hstep, voffB); PG8_STAGE(PG8_SA(0, 0), a2, voffA);
            PG8_WAIT_V(8); PG8_WAIT_L(0); PG8_BAR; PG8_MMA(1, 0, At, B0); PG8_MMA(1, 1, At, B1); PG8_BAR; PG8_SCHED;
            PG8_LDB(B0, 1, 0); PG8_LDB(B1, 1, 1); PG8_SCHED; PG8_LDA(At, 1, 0); PG8_STAGE(PG8_SA(0, 1), a2 + hstep, voffA);
            PG8_WAIT_V(8); PG8_WAIT_L(0); PG8_BAR; PG8_MMA(0, 0, At, B0); PG8_MMA(0, 1, At, B1); PG8_BAR; PG8_SCHED;
            PG8_LDA(At, 1, 1); PG8_STAGE(PG8_SB(1, 0), b3, voffB); PG8_STAGE(PG8_SB(1, 1), b3 + hstep, voffB); PG8_STAGE(PG8_SA(1, 0), a3, voffA);
            PG8_WAIT_V(8); PG8_WAIT_L(0); PG8_BAR; PG8_MMA(1, 0, At, B0); PG8_MMA(1, 1, At, B1); PG8_BAR; PG8_SCHED;
            } else {
            PG8_LDB(B0, 0, 0); PG8_SCHED; PG8_LDA(At, 0, 0); PG8_STAGE(PG8_SA(1, 1), a1 + hstep, voffA);
            PG8_WAIT_L(8); PG8_BAR; PG8_WAIT_L(0); PG8_MMA(0, 0, At, B0); PG8_BAR; PG8_SCHED;
            PG8_LDB(B1, 0, 1); PG8_STAGE(PG8_SB(0, 0), b2, voffB);
            PG8_BAR; PG8_WAIT_L(0); PG8_MMA(0, 1, At, B1); PG8_BAR;
            PG8_LDA(At, 0, 1); PG8_STAGE(PG8_SA(0, 0), a2, voffA);
            PG8_BAR; PG8_WAIT_L(0); PG8_MMA(1, 0, At, B0); PG8_BAR; PG8_SCHED;
            PG8_STAGE(PG8_SB(0, 1), b2 + hstep, voffB);
            PG8_WAIT_V(6); PG8_BAR; PG8_MMA(1, 1, At, B1); PG8_BAR;
            PG8_LDB(B0, 1, 0); PG8_SCHED; PG8_LDA(At, 1, 0); PG8_STAGE(PG8_SA(0, 1), a2 + hstep, voffA);
            PG8_WAIT_L(8); PG8_BAR; PG8_WAIT_L(0); PG8_MMA(0, 0, At, B0); PG8_BAR; PG8_SCHED;
            PG8_LDB(B1, 1, 1); PG8_STAGE(PG8_SB(1, 0), b3, voffB);
            PG8_BAR; PG8_WAIT_L(0); PG8_MMA(0, 1, At, B1); PG8_BAR;
            PG8_LDA(At, 1, 1); PG8_STAGE(PG8_SA(1, 0), a3, voffA);
            PG8_BAR; PG8_WAIT_L(0); PG8_MMA(1, 0, At, B0); PG8_BAR; PG8_SCHED;
            PG8_STAGE(PG8_SB(1, 1), b3 + hstep, voffB);
            PG8_WAIT_V(6); PG8_BAR; PG8_MMA(1, 1, At, B1); PG8_BAR;
            }
        }
        if constexpr (ALIGN_EPI) { if (wr == 0) PG8_BAR; }
        if constexpr (!Epi::AFTER_DRAIN) { E(acc, cur, wr, wc, fr, fq); S.done(cur); }
        if (!has_next) break;
#pragma unroll
        for (int a = 0; a < 2; ++a)
#pragma unroll
            for (int b = 0; b < 2; ++b)
#pragma unroll
                for (int m = 0; m < 4; ++m)
#pragma unroll
                    for (int n = 0; n < 2; ++n) acc[a][b][m][n] = (f32x4){0.f, 0.f, 0.f, 0.f};
        cur = nxt; cA = nA; cB = nB; ++ui;
        if constexpr (ALIGN_EPI) { if (wr == 1) PG8_BAR; }
    }
    PG8_WAIT_V(0);
    if constexpr (!ALIGN_EPI) { if (wr == 0) PG8_BAR; }
    PG8_BAR;
#undef PG8_SA
#undef PG8_SB
#undef PG8_STAGE
#undef PG8_LDA
#undef PG8_LDB
#undef PG8_MMA
#undef PG8_WAIT_V
#undef PG8_WAIT_L
#undef PG8_BAR
#undef PG8_SCHED
}
}

typedef unsigned short bf16_t;
typedef float f32x4 __attribute__((ext_vector_type(4)));
typedef unsigned u32x4 __attribute__((ext_vector_type(4)));
typedef unsigned u32x2 __attribute__((ext_vector_type(2)));
typedef short bf16x8 __attribute__((ext_vector_type(8)));
#define LAS __attribute__((address_space(3)))

constexpr int NWAVES = 8;
constexpr int SEQ = 4096, NB = 8, TOK = NB * SEQ, DM = 1024, FF = 2816, NP = 1792;
constexpr int OFF_GATE = 256, OFF_Q = 512, OFF_K = 1024, OFF_V = 1152, OFF_GLU = 1280;
constexpr float NORM_EPS = 1e-6f, LN_EPS = 1e-5f;

constexpr size_t MiB = 1u << 20;
constexpr size_t W_GU = (size_t)2 * FF * DM * 2, W_DOWN = (size_t)DM * FF * 2, W_IN = (size_t)NP * DM * 2, W_OUT = (size_t)DM * DM * 2;
constexpr size_t WO_GU1 = 0, WO_DOWN1 = WO_GU1 + W_GU, WO_IN = WO_DOWN1 + W_DOWN, WO_OUT = WO_IN + W_IN, WO_GU2 = WO_OUT + W_OUT, WO_DOWN2 = WO_GU2 + W_GU, W_LAYER = WO_DOWN2 + W_DOWN;
constexpr size_t WS_W = 1 * MiB;
constexpr size_t WS_H = 80 * MiB;
constexpr size_t WS_Y = 144 * MiB;
constexpr size_t WS_ACT = 208 * MiB;
constexpr size_t WS_PROJ = 208 * MiB;
constexpr size_t WS_YMIX = 320 * MiB;
constexpr size_t WS_PH = 384 * MiB;
constexpr size_t WS_AGG = 416 * MiB;
constexpr size_t WS_RS = 417 * MiB;
constexpr size_t WS_SLOTS = 418 * MiB;
constexpr size_t SLOT_BANK = (size_t)TOK * 4 * 8;
constexpr size_t WS_END = 424 * MiB;
static_assert(WS_W + 2 * W_LAYER <= WS_H, "weights fit");

constexpr size_t CTL_CNT = 65536;
constexpr size_t CTL_CNT_BYTES = 6 * 32768;
constexpr size_t CTL_SLOTS = 524288;
constexpr int XL_OFF = 131072 + 1024;
constexpr int RSTAB_OFF = 131072 + 7168;
constexpr int LDS_BYTES = 147456;

__device__ __forceinline__ float bflo(unsigned u) { return __uint_as_float(u << 16); }
__device__ __forceinline__ float bfhi(unsigned u) { return __uint_as_float(u & 0xffff0000u); }
__device__ __forceinline__ float bf1(bf16_t u) { return __uint_as_float((unsigned)u << 16); }
__device__ __forceinline__ unsigned pk2(float lo, float hi) { return pg8::cvt_pk_bf16(lo, hi); }
#define DPP_ADD(v, ctrl) ((v) + __builtin_bit_cast(float, __builtin_amdgcn_update_dpp(0, __builtin_bit_cast(int, (v)), (ctrl), 0xF, 0xF, false)))
__device__ __forceinline__ float wave_sum(float v) {
    v = DPP_ADD(v, 0xB1);
    v = DPP_ADD(v, 0x4E);
    v = DPP_ADD(v, 0x141);
    v = DPP_ADD(v, 0x140);
    return (__builtin_bit_cast(float, __builtin_amdgcn_readlane(__builtin_bit_cast(int, v), 0)) + __builtin_bit_cast(float, __builtin_amdgcn_readlane(__builtin_bit_cast(int, v), 16))) +
           (__builtin_bit_cast(float, __builtin_amdgcn_readlane(__builtin_bit_cast(int, v), 32)) + __builtin_bit_cast(float, __builtin_amdgcn_readlane(__builtin_bit_cast(int, v), 48)));
}
__device__ __forceinline__ float sigmoidf_(float x) { return __builtin_amdgcn_rcpf(1.f + __expf(-x)); }
__device__ __forceinline__ float dot4(f32x4 a) { return (a.x * a.x + a.y * a.y) + (a.z * a.z + a.w * a.w); }
__device__ __forceinline__ float gelu_tanh(float x) {
    const float z = 0.7978845608028654f * (x + 0.044715f * x * x * x);
    const float t = 1.f - 2.f * __builtin_amdgcn_rcpf(__expf(2.f * z) + 1.f);
    return 0.5f * x * (1.f + t);
}

__device__ __forceinline__ void transpose_item(const float* W, int K, int N, bf16_t* WT, bool gu, const float* gain, int item, int lane) {
    const int nblk = N / 64, kb = item / nblk, nb = item % nblk, k0 = 64 * kb, n = 64 * nb + lane;
    float v[64];
    const float* wp = W + (size_t)k0 * N + n;
#pragma unroll
    for (int i = 0; i < 64; ++i) v[i] = __builtin_nontemporal_load(wp + (size_t)i * N);
    if (gain) {
#pragma unroll
        for (int i = 0; i < 64; ++i) v[i] *= gain[k0 + i]; }
    int row = n;
    if (gu) { const int bj = n / FF, r = n % FF, pn = r / 128, j = r % 128; row = 256 * pn + 128 * bj + j; }
    bf16_t* dst = WT + (size_t)row * K + k0;
#pragma unroll
    for (int c = 0; c < 8; ++c) { u32x4 o; o.x = pk2(v[8 * c], v[8 * c + 1]); o.y = pk2(v[8 * c + 2], v[8 * c + 3]); o.z = pk2(v[8 * c + 4], v[8 * c + 5]); o.w = pk2(v[8 * c + 6], v[8 * c + 7]);
        *(u32x4*)(dst + 8 * c) = o; }
}

template <int MODE>
__device__ __forceinline__ void norm_phase(int gw, int NGW, int lane, const float* xin, float* xout, bf16_t* XB, const bf16_t* Y, const float* post_g, float scale, float* rs) {
    constexpr bool XF32 = (MODE == 0 || MODE == 3), HASY = (MODE != 0);
    f32x4 qg[4];
#pragma unroll
    for (int j = 0; j < 4; ++j) qg[j] = HASY ? ((const f32x4*)post_g)[lane + 64 * j] : (f32x4){0.f, 0.f, 0.f, 0.f};
    f32x4 v[4]; u32x2 xw[4], yw[4];
    if (gw < TOK) {
        if (XF32) { const f32x4* xr = (const f32x4*)(xin + (size_t)gw * DM) + lane;
#pragma unroll
            for (int j = 0; j < 4; ++j) v[j] = __builtin_nontemporal_load(xr + 64 * j); }
        else { const u32x2* xr = (const u32x2*)(XB + (size_t)gw * DM) + lane;
#pragma unroll
            for (int j = 0; j < 4; ++j) xw[j] = xr[64 * j]; }
        if (HASY) { const u32x2* yr = (const u32x2*)(Y + (size_t)gw * DM) + lane;
#pragma unroll
            for (int j = 0; j < 4; ++j) yw[j] = yr[64 * j]; }
    }
    for (int m = gw; m < TOK; m += NGW) {
        f32x4 vn[4]; u32x2 xwn[4], ywn[4];
        const int mn = (m + NGW < TOK) ? m + NGW : m;
        {
            if (XF32) { const f32x4* xr = (const f32x4*)(xin + (size_t)mn * DM) + lane;
#pragma unroll
                for (int j = 0; j < 4; ++j) vn[j] = __builtin_nontemporal_load(xr + 64 * j); }
            else { const u32x2* xr = (const u32x2*)(XB + (size_t)mn * DM) + lane;
#pragma unroll
                for (int j = 0; j < 4; ++j) xwn[j] = xr[64 * j]; }
            if (HASY) { const u32x2* yr = (const u32x2*)(Y + (size_t)mn * DM) + lane;
#pragma unroll
                for (int j = 0; j < 4; ++j) ywn[j] = yr[64 * j]; }
        }
        if (!XF32) {
#pragma unroll
            for (int j = 0; j < 4; ++j) v[j] = (f32x4){bflo(xw[j].x), bfhi(xw[j].x), bflo(xw[j].y), bfhi(xw[j].y)};
        }
        if (HASY) {
            f32x4 y[4]; float ss = 0.f;
#pragma unroll
            for (int j = 0; j < 4; ++j) { const u32x2 w = yw[j]; y[j] = (f32x4){bflo(w.x), bfhi(w.x), bflo(w.y), bfhi(w.y)}; ss += dot4(y[j]); }
            ss = wave_sum(ss);
            const float r = rsqrtf(ss * (1.f / DM) + NORM_EPS) * scale;
#pragma unroll
            for (int j = 0; j < 4; ++j) v[j] = v[j] + y[j] * r * qg[j];
        }
        if (MODE == 2) {
            f32x4* xo = (f32x4*)(xout + (size_t)m * DM) + lane;
#pragma unroll
            for (int j = 0; j < 4; ++j) xo[64 * j] = v[j];
        } else {
            float ss = 0.f;
#pragma unroll
            for (int j = 0; j < 4; ++j) ss += dot4(v[j]);
            ss = wave_sum(ss);
            if (lane == 0) *(f32x4*)(rs + (size_t)m * 4) = (f32x4){ss, 0.f, 0.f, 0.f};
            u32x2* ho = (u32x2*)(XB + (size_t)m * DM) + lane;
#pragma unroll
            for (int j = 0; j < 4; ++j) { u32x2 w; w.x = pk2(v[j].x, v[j].y); w.y = pk2(v[j].z, v[j].w); ho[64 * j] = w; }
        }
#pragma unroll
        for (int j = 0; j < 4; ++j) { if (XF32) v[j] = vn[j]; else xw[j] = xwn[j]; if (HASY) yw[j] = ywn[j]; }
    }
}

typedef __bf16 bf16x2_t __attribute__((ext_vector_type(2)));
__device__ __forceinline__ float dot2bf(unsigned a, unsigned b, float c) { return __builtin_amdgcn_fdot2_f32_bf16(__builtin_bit_cast(bf16x2_t, a), __builtin_bit_cast(bf16x2_t, b), c, false); }
__device__ __forceinline__ void lru_local_item(int item, int lane, unsigned char* wl  , const bf16_t* proj,
                                               const float* cw, const float* cbias, const float* wa, const float* ba, const float* wx, const float* bx, const float* lam,
                                               unsigned* PH, float* AGG) {
    bf16_t* xc = (bf16_t*)wl;
    float* ab = (float*)(wl + 9216);
    const int b = item >> 8, c = (item >> 2) & 63, hb = item & 3;
    const int ch = hb * 64 + lane;
    const int q16 = lane & 15, g = lane >> 4;
    const size_t tok0 = (size_t)b * SEQ + (size_t)c * 64;
    const float w0 = cw[ch], w1 = cw[256 + ch], w2 = cw[512 + ch], w3 = cw[768 + ch], cb = cbias[ch];
    const bf16_t* xp = proj + tok0 * NP + ch;
    float xm3 = 0.f, xm2 = 0.f, xm1 = 0.f;
    if (c > 0) { xm3 = bf1(xp[-3 * NP]); xm2 = bf1(xp[-2 * NP]); xm1 = bf1(xp[-1 * NP]); }
    bf16_t xin[64];
#pragma unroll
    for (int t = 0; t < 64; ++t) xin[t] = xp[(size_t)t * NP];
    bf16x8 Wa[4][2], Wx[4][2];
    {
        const float* wap = wa + hb * 4096 + (8 * g) * 64 + q16; const float* wxp = wx + hb * 4096 + (8 * g) * 64 + q16;
#pragma unroll
        for (int ct = 0; ct < 4; ++ct)
#pragma unroll
            for (int ks = 0; ks < 2; ++ks) {
                const float* pa = wap + ks * 32 * 64 + ct * 16; const float* px = wxp + ks * 32 * 64 + ct * 16;
                u32x4 va, vx;
                va.x = pk2(pa[0], pa[64]); va.y = pk2(pa[128], pa[192]); va.z = pk2(pa[256], pa[320]); va.w = pk2(pa[384], pa[448]);
                vx.x = pk2(px[0], px[64]); vx.y = pk2(px[128], px[192]); vx.z = pk2(px[256], px[320]); vx.w = pk2(px[384], px[448]);
                Wa[ct][ks] = __builtin_bit_cast(bf16x8, va); Wx[ct][ks] = __builtin_bit_cast(bf16x8, vx);
            }
    }
    float bav[4], bxv[4], sp8[4];
#pragma unroll
    for (int ct = 0; ct < 4; ++ct) { const int cc = hb * 64 + ct * 16 + q16; bav[ct] = ba[cc]; bxv[ct] = bx[cc]; sp8[ct] = -8.f * log1pf(__expf(-lam[cc])); }
#pragma unroll
    for (int t = 0; t < 64; ++t) {
        const float x0 = bf1(xin[t]);
        const float v = cb + w0 * xm3 + w1 * xm2 + w2 * xm1 + w3 * x0;
        xc[t * 72 + lane] = (bf16_t)(pk2(v, v) & 0xffffu);
        xm3 = xm2; xm2 = xm1; xm1 = x0;
    }
    float h = 0.f, P = 1.f;
    unsigned* php = PH + tok0 * 256 + ch;
#pragma unroll 1
    for (int T = 0; T < 4; ++T) {
        const bf16_t* arow = xc + (T * 16 + q16) * 72 + 8 * g;
        const bf16x8 A0 = *(const bf16x8*)arow, A1 = *(const bf16x8*)(arow + 32);
#pragma unroll
        for (int ct = 0; ct < 4; ++ct) {
            f32x4 r = (f32x4){0.f, 0.f, 0.f, 0.f}, ii = (f32x4){0.f, 0.f, 0.f, 0.f};
            r = __builtin_amdgcn_mfma_f32_16x16x32_bf16(A0, Wa[ct][0], r, 0, 0, 0); r = __builtin_amdgcn_mfma_f32_16x16x32_bf16(A1, Wa[ct][1], r, 0, 0, 0);
            ii = __builtin_amdgcn_mfma_f32_16x16x32_bf16(A0, Wx[ct][0], ii, 0, 0, 0); ii = __builtin_amdgcn_mfma_f32_16x16x32_bf16(A1, Wx[ct][1], ii, 0, 0, 0);
#pragma unroll
            for (int e = 0; e < 4; ++e) {
                const int tl = 4 * g + e;
                const float xcv = bf1(xc[(T * 16 + tl) * 72 + ct * 16 + q16]);
                const float rr = sigmoidf_(r[e] + bav[ct]), ig = sigmoidf_(ii[e] + bxv[ct]);
                const float av = __expf(sp8[ct] * rr);
                const float bv = sqrtf(fmaxf(1.f - av * av, 0.f)) * ig * xcv;
                *(float2*)(ab + (tl * 64 + ct * 16 + q16) * 2) = make_float2(av, bv);
            }
        }
#pragma unroll 4
        for (int t = 0; t < 16; ++t) {
            const float2 v = *(const float2*)(ab + (t * 64 + lane) * 2);
            h = v.x * h + v.y; P *= v.x;
            __builtin_nontemporal_store(pk2(P, h), php + (size_t)(T * 16 + t) * 256);
        }
    }
    float* ag = AGG + ((size_t)(b * 64 + c) * 256 + ch) * 2;
    ag[0] = P; ag[1] = h;
}

__device__ __forceinline__ void attn_item(int item, unsigned char* smem, int tid, int lane, int wave, const bf16_t* proj, const float* sinks, bf16_t* ymix) {
    const int b = item >> 6, kvh = (item >> 5) & 1, qb = item & 31;
    bf16_t* Ks = (bf16_t*)smem;
    bf16_t* Vt = (bf16_t*)(smem + 36864);
    const long tokb = (long)b * SEQ + (long)(qb - 1) * 128;
#pragma unroll
    for (int i = 0; i < 4; ++i) {
        const int p = tid + 512 * i; const int row = p >> 3, c8 = p & 7;
        u32x4 kv = (u32x4){0u, 0u, 0u, 0u}, vv = (u32x4){0u, 0u, 0u, 0u};
        if (qb > 0 || row >= 128) {
            const bf16_t* src = proj + (tokb + row) * NP;
            kv = *(const u32x4*)(src + OFF_K + kvh * 64 + c8 * 8);
            vv = *(const u32x4*)(src + OFF_V + kvh * 64 + c8 * 8);
        }
        *(u32x4*)(Ks + row * 72 + c8 * 8) = kv;
        bf16_t* vd = Vt + (c8 * 8) * 264 + row;
        vd[0 * 264] = (bf16_t)(vv.x & 0xffffu); vd[1 * 264] = (bf16_t)(vv.x >> 16);
        vd[2 * 264] = (bf16_t)(vv.y & 0xffffu); vd[3 * 264] = (bf16_t)(vv.y >> 16);
        vd[4 * 264] = (bf16_t)(vv.z & 0xffffu); vd[5 * 264] = (bf16_t)(vv.z >> 16);
        vd[6 * 264] = (bf16_t)(vv.w & 0xffffu); vd[7 * 264] = (bf16_t)(vv.w >> 16);
    }
    __syncthreads();
    const int hq = kvh * 4 + (wave & 3), half = wave >> 2, kstart = half * 64;
    const int q16 = lane & 15, g = lane >> 4;
    const float sink = sinks[hq];
    bf16x8 qn0, qn1;
    { const bf16_t* qp = proj + ((size_t)b * SEQ + (size_t)qb * 128 + half * 64 + q16) * NP + OFF_Q + hq * 64 + 8 * g; qn0 = *(const bf16x8*)qp; qn1 = *(const bf16x8*)(qp + 32); }
#pragma unroll 1
    for (int qt = 0; qt < 4; ++qt) {
        const int qloc = half * 64 + qt * 16 + q16;
        const int qband = 128 + qloc;
        const size_t qtok = (size_t)b * SEQ + (size_t)qb * 128 + qloc;
        const bf16x8 qf0 = qn0, qf1 = qn1;
        { const int qtn = qt < 3 ? qt + 1 : qt;
          const bf16_t* qp = proj + ((size_t)b * SEQ + (size_t)qb * 128 + half * 64 + qtn * 16 + q16) * NP + OFF_Q + hq * 64 + 8 * g; qn0 = *(const bf16x8*)qp; qn1 = *(const bf16x8*)(qp + 32); }
        f32x4 s[9];
        const int kt0 = kstart + qt * 16;
#pragma unroll
        for (int j = 0; j < 9; ++j) {
            const bf16_t* kp = Ks + (kt0 + j * 16 + q16) * 72 + 8 * g;
            const bf16x8 k0 = *(const bf16x8*)kp, k1 = *(const bf16x8*)(kp + 32);
            f32x4 a = (f32x4){0.f, 0.f, 0.f, 0.f};
            a = __builtin_amdgcn_mfma_f32_16x16x32_bf16(k0, qf0, a, 0, 0, 0);
            a = __builtin_amdgcn_mfma_f32_16x16x32_bf16(k1, qf1, a, 0, 0, 0);
            s[j] = a;
        }
        float m = -1e30f;
#pragma unroll
        for (int j = 0; j < 9; ++j) {
            const bool dead = (qb == 0) && (kt0 + j * 16 < 128);
#pragma unroll
            for (int e = 0; e < 4; ++e) {
                float v = dead ? -1e30f : s[j][e] * 0.125f;
                if (j == 0) v = (4 * g + e > q16) ? v : -1e30f;
                if (j == 8) v = (4 * g + e <= q16) ? v : -1e30f;
                s[j][e] = v; m = fmaxf(m, v);
            }
        }
        m = fmaxf(m, __shfl_xor(m, 16)); m = fmaxf(m, __shfl_xor(m, 32)); m = fmaxf(m, sink);
        float sum = 0.f;
#pragma unroll
        for (int j = 0; j < 9; ++j)
#pragma unroll
            for (int e = 0; e < 4; ++e) { const float p = __expf(s[j][e] - m); s[j][e] = p; sum += p; }
        sum += __shfl_xor(sum, 16); sum += __shfl_xor(sum, 32);
        const float inv = 1.f / (sum + __expf(sink - m));
        bf16x8 pf[5];
#pragma unroll
        for (int kk = 0; kk < 4; ++kk) {
            u32x4 w; w.x = pk2(s[2 * kk][0], s[2 * kk][1]); w.y = pk2(s[2 * kk][2], s[2 * kk][3]); w.z = pk2(s[2 * kk + 1][0], s[2 * kk + 1][1]); w.w = pk2(s[2 * kk + 1][2], s[2 * kk + 1][3]);
            pf[kk] = __builtin_bit_cast(bf16x8, w);
        }
        { u32x4 w; w.x = pk2(s[8][0], s[8][1]); w.y = pk2(s[8][2], s[8][3]); w.z = 0u; w.w = 0u; pf[4] = __builtin_bit_cast(bf16x8, w); }
        bf16_t* op = ymix + qtok * DM + 256 + hq * 64 + 4 * g;
#pragma unroll
        for (int dt = 0; dt < 4; ++dt) {
            f32x4 o = (f32x4){0.f, 0.f, 0.f, 0.f};
#pragma unroll
            for (int kk = 0; kk < 5; ++kk) {
                const bf16_t* vp = Vt + (dt * 16 + q16) * 264 + kt0 + kk * 32 + 4 * g;
                const u32x2 lo = *(const u32x2*)vp, hi = (kk < 4) ? *(const u32x2*)(vp + 16) : lo;
                const u32x4 vw = (u32x4){lo.x, lo.y, hi.x, hi.y};
                o = __builtin_amdgcn_mfma_f32_16x16x32_bf16(__builtin_bit_cast(bf16x8, vw), pf[kk], o, 0, 0, 0);
            }
            u32x2 w; w.x = pk2(o[0] * inv, o[1] * inv); w.y = pk2(o[2] * inv, o[3] * inv);
            __builtin_nontemporal_store(w, (u32x2*)(op + dt * 16));
        }
    }
    __syncthreads();
}

__device__ __forceinline__ void conf_phase(int bx, int G, unsigned char* smem, int tid, int lane, int wave, const bf16_t* proj,
                                           const float* cw, const float* cbias, const float* lng, const float* lnb, const float* gg, bf16_t* ymix) {
    constexpr int NITEM = NB * 128;
    float* st = (float*)smem;
    float* ot = (float*)(smem + 63488);
    const int ch = tid & 255, th = tid >> 8;
    float w[31];
#pragma unroll
    for (int k = 0; k < 31; ++k) w[k] = cw[k * 256 + ch];
    const float bias = cbias[ch];
    const f32x4 lg = ((const f32x4*)lng)[lane], lb = ((const f32x4*)lnb)[lane], ggv = ((const f32x4*)gg)[lane];
    u32x4 rav[4], rgv[4];
#define CONF_FETCH(item) do { const int b_ = (item) >> 7, t0_ = ((item) & 127) * 32; _Pragma("unroll") for (int i = 0; i < 4; ++i) { const int p = tid + 512 * i; const int row = p >> 5, c8 = p & 31; const int t = t0_ - 30 + row; \
        rav[i] = (u32x4){0u, 0u, 0u, 0u}; rgv[i] = (u32x4){0u, 0u, 0u, 0u}; \
        if (p < 62 * 32 && t >= 0) { const bf16_t* src = proj + ((size_t)b_ * SEQ + t) * NP + OFF_GLU + c8 * 8; rav[i] = __builtin_nontemporal_load((const u32x4*)src); rgv[i] = __builtin_nontemporal_load((const u32x4*)(src + 256)); } } } while (0)
    if (bx < NITEM) CONF_FETCH(bx);
    for (int item = bx; item < NITEM; item += G) {
        const int b = item >> 7, t0 = (item & 127) * 32;
#pragma unroll
        for (int i = 0; i < 4; ++i) {
            const int p = tid + 512 * i; const int row = p >> 5, c8 = p & 31;
            if (p < 62 * 32) {
                const u32x4 av = rav[i], gv = rgv[i];
                f32x4 y0, y1;
                y0.x = bflo(av.x) * sigmoidf_(bflo(gv.x)); y0.y = bfhi(av.x) * sigmoidf_(bfhi(gv.x));
                y0.z = bflo(av.y) * sigmoidf_(bflo(gv.y)); y0.w = bfhi(av.y) * sigmoidf_(bfhi(gv.y));
                y1.x = bflo(av.z) * sigmoidf_(bflo(gv.z)); y1.y = bfhi(av.z) * sigmoidf_(bfhi(gv.z));
                y1.z = bflo(av.w) * sigmoidf_(bflo(gv.w)); y1.w = bfhi(av.w) * sigmoidf_(bfhi(gv.w));
                *(f32x4*)(st + row * 256 + c8 * 8) = y0; *(f32x4*)(st + row * 256 + c8 * 8 + 4) = y1;
            }
        }
        __syncthreads();
        if (item + G < NITEM) CONF_FETCH(item + G);
#pragma unroll 1
        for (int gi = 0; gi < 2; ++gi) {
            const int tau0 = th * 16 + gi * 8;
            float in[38];
#pragma unroll
            for (int i = 0; i < 38; ++i) in[i] = st[(tau0 + i) * 256 + ch];
#pragma unroll
            for (int o = 0; o < 8; ++o) { float acc = bias;
#pragma unroll
                for (int k = 0; k < 31; ++k) acc += w[k] * in[o + k];
                ot[(tau0 + o) * 256 + ch] = acc; }
        }
        __syncthreads();
#pragma unroll 2
        for (int i = 0; i < 4; ++i) {
            const int tau = wave * 4 + i;
            const f32x4 v = *(const f32x4*)(ot + tau * 256 + 4 * lane);
            const float mu = wave_sum((v.x + v.y) + (v.z + v.w)) * (1.f / 256.f);
            const f32x4 d = v - mu;
            const float rstd = rsqrtf(wave_sum(dot4(d)) * (1.f / 256.f) + LN_EPS);
            f32x4 y = d * rstd * lg + lb;
            y.x *= sigmoidf_(y.x); y.y *= sigmoidf_(y.y); y.z *= sigmoidf_(y.z); y.w *= sigmoidf_(y.w);
            const float r = rsqrtf(wave_sum(dot4(y)) * (1.f / 256.f) + NORM_EPS);
            const f32x4 o = y * r * ggv;
            u32x2 wv; wv.x = pk2(o.x, o.y); wv.y = pk2(o.z, o.w);
            *(u32x2*)(ymix + ((size_t)b * SEQ + t0 + tau) * DM + 768 + 4 * lane) = wv;
        }
    }
#undef CONF_FETCH
    __syncthreads();
}

__device__ __forceinline__ void mix2_item(int item, unsigned char* smem, int tid, int lane, int wave, const bf16_t* proj, const unsigned* PH, const float* AGG, const float* gg, bf16_t* ymix) {
    const int b = item >> 6, c = item & 63;
    float* segA = (float*)smem;
    float* segH = (float*)(smem + 8192);
    {
        const int seg = (c + 7) >> 3; const int c0 = wave * seg; const int c1 = (c0 + seg < c) ? c0 + seg : c;
        const float* ag = AGG + ((size_t)(b * 64) * 256 + 4 * lane) * 2;
        f32x4 lo[8], hi[8];
#pragma unroll
        for (int k = 0; k < 8; ++k) { const int cc = c0 + k;
            if (cc < c1) { lo[k] = *(const f32x4*)(ag + (size_t)cc * 512); hi[k] = *(const f32x4*)(ag + (size_t)cc * 512 + 4); }
            else { lo[k] = (f32x4){1.f, 0.f, 1.f, 0.f}; hi[k] = (f32x4){1.f, 0.f, 1.f, 0.f}; } }
        f32x4 A = (f32x4){1.f, 1.f, 1.f, 1.f}, Hh = (f32x4){0.f, 0.f, 0.f, 0.f};
#pragma unroll
        for (int k = 0; k < 8; ++k) {
            Hh.x = lo[k].x * Hh.x + lo[k].y; A.x *= lo[k].x; Hh.y = lo[k].z * Hh.y + lo[k].w; A.y *= lo[k].z;
            Hh.z = hi[k].x * Hh.z + hi[k].y; A.z *= hi[k].x; Hh.w = hi[k].z * Hh.w + hi[k].w; A.w *= hi[k].z; }
        *(f32x4*)(segA + wave * 256 + 4 * lane) = A; *(f32x4*)(segH + wave * 256 + 4 * lane) = Hh;
    }
    __syncthreads();
    f32x4 cr4 = (f32x4){0.f, 0.f, 0.f, 0.f};
#pragma unroll
    for (int sgi = 0; sgi < 8; ++sgi) { const f32x4 a = *(const f32x4*)(segA + sgi * 256 + 4 * lane), hh = *(const f32x4*)(segH + sgi * 256 + 4 * lane); cr4 = a * cr4 + hh; }
    const f32x4 ga = ((const f32x4*)gg)[lane];
    const f32x4 gb0 = ((const f32x4*)(gg + 256))[2 * lane], gb1 = ((const f32x4*)(gg + 256))[2 * lane + 1];
    const size_t tokb = (size_t)b * SEQ + (size_t)c * 64 + wave * 8;
    u32x4 phv[8], ovv[8]; u32x2 gtv[8];
#pragma unroll
    for (int i = 0; i < 8; ++i) {
        phv[i] = __builtin_nontemporal_load((const u32x4*)(PH + (tokb + i) * 256 + 4 * lane));
        gtv[i] = __builtin_nontemporal_load((const u32x2*)(proj + (tokb + i) * NP + OFF_GATE + 4 * lane));
        ovv[i] = __builtin_nontemporal_load((const u32x4*)(ymix + (tokb + i) * DM + 256 + 8 * lane));
    }
#pragma unroll
    for (int i = 0; i < 8; ++i) {
        const u32x4 ph = phv[i]; const u32x2 gt = gtv[i]; const u32x4 ov = ovv[i];
        f32x4 ya;
        ya.x = gelu_tanh(bflo(gt.x)) * (bfhi(ph.x) + bflo(ph.x) * cr4.x);
        ya.y = gelu_tanh(bfhi(gt.x)) * (bfhi(ph.y) + bflo(ph.y) * cr4.y);
        ya.z = gelu_tanh(bflo(gt.y)) * (bfhi(ph.z) + bflo(ph.z) * cr4.z);
        ya.w = gelu_tanh(bfhi(gt.y)) * (bfhi(ph.w) + bflo(ph.w) * cr4.w);
        const float ra = rsqrtf(wave_sum(dot4(ya)) * (1.f / 256.f) + NORM_EPS);
        const f32x4 oa = ya * ra * ga;
        u32x2 wv; wv.x = pk2(oa.x, oa.y); wv.y = pk2(oa.z, oa.w);
        bf16_t* yrow = ymix + (tokb + i) * DM;
        *(u32x2*)(yrow + 4 * lane) = wv;
        f32x4 b0 = (f32x4){bflo(ov.x), bfhi(ov.x), bflo(ov.y), bfhi(ov.y)}, b1 = (f32x4){bflo(ov.z), bfhi(ov.z), bflo(ov.w), bfhi(ov.w)};
        const float rb = rsqrtf(wave_sum(dot4(b0) + dot4(b1)) * (1.f / 512.f) + NORM_EPS);
        b0 = b0 * rb * gb0; b1 = b1 * rb * gb1;
        u32x4 ow; ow.x = pk2(b0.x, b0.y); ow.y = pk2(b0.z, b0.w); ow.z = pk2(b1.x, b1.y); ow.w = pk2(b1.z, b1.w);
        *(u32x4*)(yrow + 256 + 8 * lane) = ow;
    }
    __syncthreads();
}


#define XB_TMO      128
#define XB_XCNT(j)  (256  + 64 * (j))
#define XB_XSUB(j)  (1280 + 64 * (j))
#define XB_XGEN(j)  (2304 + 64 * (j))
#define XB_TOP      3328
#define XB_TOPGEN   3392
#define XCD_BAR_WORDS 3456
#define XB_SPIN_CAP (1u << 18)
__device__ __forceinline__ unsigned xb_ld(unsigned* p)              { return __hip_atomic_load(p, __ATOMIC_RELAXED, __HIP_MEMORY_SCOPE_AGENT); }
__device__ __forceinline__ unsigned xb_add(unsigned* p, unsigned v) { return __hip_atomic_fetch_add(p, v, __ATOMIC_RELAXED, __HIP_MEMORY_SCOPE_AGENT); }
__device__ __forceinline__ unsigned xb_xcc_id() { return (unsigned)__builtin_amdgcn_s_getreg((3 << 11) | 20) & 0xFu; }
#define XB_SPIN(cond, bar) do { unsigned _sp = 0; while (cond) { __builtin_amdgcn_s_sleep(1); \
    if ((++_sp & 255u) == 0u) { if (xb_ld(&(bar)[XB_TMO])) break; if (_sp > XB_SPIN_CAP) { atomicAdd(&(bar)[XB_TMO], 1u); break; } } } } while (0)
struct XcdBarrier { unsigned* bar; unsigned x; volatile LAS unsigned* st; };
__device__ __forceinline__ void xcd_barrier_complete(unsigned* bar, unsigned x, unsigned& nloc, unsigned& nx) {
    const unsigned G = gridDim.x * gridDim.y * gridDim.z;
    unsigned sum, cnt, mine, sp = 0u;
    for (;;) {
        sum = 0u; cnt = 0u; mine = 0u;
#pragma unroll
        for (unsigned j = 0; j < 16; ++j) { const unsigned c = xb_ld(&bar[XB_XCNT(j)]); sum += c; cnt += (c > 0u) ? 1u : 0u; mine = (j == x) ? c : mine; }
        if (sum == G) break;
        __builtin_amdgcn_s_sleep(1);
        if ((++sp & 255u) == 0u) { if (xb_ld(&bar[XB_TMO])) break; if (sp > XB_SPIN_CAP) { atomicAdd(&bar[XB_TMO], 1u); break; } }
    }
    nloc = mine > 0u ? mine : 1u; nx = cnt > 0u ? cnt : 1u;
}
__device__ __forceinline__ void xcd_barrier(const XcdBarrier& b) {
    asm volatile("s_waitcnt vmcnt(0)" ::: "memory");
    __syncthreads();
    if (threadIdx.x == 0) {
        unsigned* bar = b.bar;
        __builtin_amdgcn_s_waitcnt(0);
        unsigned nloc = b.st[0], nx = b.st[1];
        if (nloc == 0u) { xcd_barrier_complete(bar, b.x, nloc, nx); b.st[0] = nloc; b.st[1] = nx; }
        const unsigned old = xb_add(&bar[XB_XSUB(b.x)], 1u);
        const unsigned gen = old / nloc;
        if (old + 1u == (gen + 1u) * nloc) {
            __builtin_amdgcn_fence(__ATOMIC_RELEASE, "agent");
            asm volatile("s_waitcnt vmcnt(0)" ::: "memory");
            const unsigned og = xb_add(&bar[XB_TOP], 1u);
            const unsigned tg = og / nx;
            if (og + 1u == (tg + 1u) * nx) xb_add(&bar[XB_TOPGEN], 1u);
            else XB_SPIN(xb_ld(&bar[XB_TOPGEN]) == tg, bar);
            __builtin_amdgcn_fence(__ATOMIC_ACQUIRE, "agent");
            xb_add(&bar[XB_XGEN(b.x)], 1u);
            asm volatile("s_waitcnt vmcnt(0)" ::: "memory");
        } else {
            XB_SPIN(xb_ld(&bar[XB_XGEN(b.x)]) == gen, bar);
            __builtin_amdgcn_fence(__ATOMIC_ACQUIRE, "agent");
            asm volatile("s_waitcnt vmcnt(0)" ::: "memory");
        }
    }
    __syncthreads();
}
constexpr int MISC_OFF = 147456 - 16;

struct Args { const float* in[26]; float* out; unsigned char* ws; };

__device__ __forceinline__ const Args* args_ptr() {
    const Args* ap = (const Args*)__builtin_amdgcn_kernarg_segment_ptr();
    asm volatile("" : "+s"(ap));
    return ap;
}
#define GAS __attribute__((address_space(1)))
struct ArgsG { GAS const float* in[26]; GAS float* out; GAS unsigned char* ws; };
#define WSP(off) ((unsigned char*)(((const ArgsG*)ap)->ws + (off)))
#define AIN(k) ((const float*)(((const ArgsG*)ap)->in[k]))
#define AOUT ((float*)(((const ArgsG*)ap)->out))

#ifndef REP_GEMM
#define REP_GEMM 1
#endif
#ifndef REP_SYNC
#define REP_SYNC 1
#endif
#ifndef REP_MIX
#define REP_MIX 1
#endif
#ifndef REP_NORM
#define REP_NORM 1
#endif
#ifndef REP_P0
#define REP_P0 1
#endif
#define GSYNC() do { _Pragma("nounroll") for (int r_ = 0; r_ < REP_SYNC; ++r_) { const Args* ap_ = args_ptr(); XcdBarrier b_; b_.bar = (unsigned*)(((const ArgsG*)ap_)->ws); b_.x = xb_xcc_id(); b_.st = (volatile LAS unsigned*)(ldsl + MISC_OFF); xcd_barrier(b_); } } while (0)
#define TID_VARS int tid_ = threadIdx.x; asm volatile("" : "+v"(tid_)); const int tid = tid_, lane = tid & 63, wave = __builtin_amdgcn_readfirstlane(tid >> 6); int G_ = gridDim.x, bx_ = blockIdx.x; asm volatile("" : "+s"(G_), "+s"(bx_)); const int G = G_, bx = bx_; const int gw = bx * NWAVES + wave, NGW = G * NWAVES; (void)lane; (void)gw; (void)NGW; (void)tid
#define GEMM_PHASE(EPI, AOFF, WOFF, NN, KK, OOFF, LDC, RSP) do { _Pragma("nounroll") for (int r_ = 0; r_ < REP_GEMM; ++r_) { const Args* ap = args_ptr(); \
        pg8::Gemm g{(const bf16_t*)WSP(AOFF), (const bf16_t*)WSP(WS_W + (size_t)l * W_LAYER + (WOFF)), TOK, NN, KK}; pg8::StaticOrderRS S; S.init(TOK, NN, (int)gridDim.x, (int)blockIdx.x); S.ssp = RSP; S.tab = ldsl + RSTAB_OFF; \
        pg8::EPI E{(bf16_t*)WSP(OOFF), LDC, ldsl + RSTAB_OFF}; pg8::gemm_phase<pg8::EPI, pg8::StaticOrderRS, true, true>(ldsl, g, S, E); } } while (0)
namespace pg8 {
template <bool FINAL, int GIN, int GOFF, int SCALE2, int BANK> struct EpiNormRes {
    static constexpr bool PERM = true, AFTER_DRAIN = false;
    __device__ __forceinline__ void operator()(const f32x4 (&acc)[2][2][4][2], const Unit& u, int wr_, int wc_, int fr_, int fq_) const {
        int wr = wr_, wc = wc_, fr = fr_, fq = fq_; asm volatile("" : "+s"(wr), "+s"(wc), "+v"(fr), "+v"(fq));
        const Args* ap = args_ptr();
        bf16_t* XB = (bf16_t*)WSP(WS_H); float* out = AOUT; const float* g = AIN(GIN) + GOFF; const float scale = 0.5f * SCALE2;
        unsigned long long* slots = (unsigned long long*)WSP(WS_SLOTS + (size_t)BANK * SLOT_BANK); float* ssp = (float*)WSP(WS_RS);
        PG8_LAS unsigned char* xl = (PG8_LAS unsigned char*)(XL_OFF);
        PG8_LAS float* P = (PG8_LAS float*)xl;
        PG8_LAS float* Sx = (PG8_LAS float*)(xl + 4096);
        const int lane = fr + 16 * fq, wid = wr * 4 + wc;
#pragma unroll
        for (int ai = 0; ai < 2; ++ai)
#pragma unroll
            for (int m = 0; m < 4; ++m) {
                float sq = 0.f;
#pragma unroll
                for (int bj = 0; bj < 2; ++bj)
#pragma unroll
                    for (int n = 0; n < 2; ++n) { const f32x4 x = acc[ai][bj][m][n]; sq += (x[0] * x[0] + x[1] * x[1]) + (x[2] * x[2] + x[3] * x[3]); }
                sq += __shfl_xor(sq, 16); sq += __shfl_xor(sq, 32);
                if (fq == 0) P[(ai * HALF + wr * 64 + m * 16 + fr) * 4 + wc] = sq;
            }
        asm volatile("s_waitcnt lgkmcnt(0)" ::: "memory"); __builtin_amdgcn_s_barrier(); asm volatile("" ::: "memory");
        const int col0 = u.pn * BM + wc * 32 + 8 * fq;
        f32x4 gv[2][2];
#pragma unroll
        for (int bj = 0; bj < 2; ++bj)
#pragma unroll
            for (int n = 0; n < 2; ++n) gv[bj][n] = *(const f32x4*)(g + col0 + bj * HALF + 4 * n);
        u32x4 xpre[4][2];
#pragma unroll
        for (int m = 0; m < 4; ++m)
#pragma unroll
            for (int bj = 0; bj < 2; ++bj) xpre[m][bj] = *(const u32x4*)(XB + (size_t)(u.pm * BM + wr * 64 + m * 16 + fr) * 1024 + col0 + bj * HALF);
        if (lane < 32) {
            const int row = wid * 32 + lane;
            const f32x4 p = *(const PG8_LAS f32x4*)(P + row * 4);
            unsigned long long* sl = slots + (size_t)(u.pm * BM + row) * 4;
            __hip_atomic_store(sl + u.pn, (1ull << 32) | (unsigned long long)__float_as_uint((p[0] + p[1]) + (p[2] + p[3])), __ATOMIC_RELAXED, __HIP_MEMORY_SCOPE_AGENT);
            unsigned long long w0, w1, w2, w3; unsigned sp = 0u;
            for (;;) {
                w0 = __hip_atomic_load(sl + 0, __ATOMIC_RELAXED, __HIP_MEMORY_SCOPE_AGENT); w1 = __hip_atomic_load(sl + 1, __ATOMIC_RELAXED, __HIP_MEMORY_SCOPE_AGENT);
                w2 = __hip_atomic_load(sl + 2, __ATOMIC_RELAXED, __HIP_MEMORY_SCOPE_AGENT); w3 = __hip_atomic_load(sl + 3, __ATOMIC_RELAXED, __HIP_MEMORY_SCOPE_AGENT);
                if ((((w0 >> 32) & (w1 >> 32)) & ((w2 >> 32) & (w3 >> 32))) != 0ull) break;
                __builtin_amdgcn_s_sleep(1); if (++sp > (1u << 20)) break;
            }
            const float t = (__uint_as_float((unsigned)w0) + __uint_as_float((unsigned)w1)) + (__uint_as_float((unsigned)w2) + __uint_as_float((unsigned)w3));
            Sx[row] = scale * rsqrtf(t * (1.f / 1024.f) + 1e-6f);
        }
        asm volatile("s_waitcnt vmcnt(0) lgkmcnt(0)" ::: "memory"); __builtin_amdgcn_s_barrier(); asm volatile("" ::: "memory");
#pragma unroll
        for (int ai = 0; ai < 2; ++ai)
#pragma unroll
            for (int m = 0; m < 4; ++m) {
                const int rl = ai * HALF + wr * 64 + m * 16 + fr; const size_t grow = (size_t)(u.pm * BM + rl);
                const float c = Sx[rl]; float sq = 0.f;
#pragma unroll
                for (int bj = 0; bj < 2; ++bj) {
                    bf16_t* xp = XB + grow * 1024 + col0 + bj * HALF;
                    const u32x4 xw = (ai == 0) ? xpre[m][bj] : *(const u32x4*)xp;
                    const f32x4 x0 = (f32x4){__uint_as_float(xw.x << 16), __uint_as_float(xw.x & 0xffff0000u), __uint_as_float(xw.y << 16), __uint_as_float(xw.y & 0xffff0000u)};
                    const f32x4 x1 = (f32x4){__uint_as_float(xw.z << 16), __uint_as_float(xw.z & 0xffff0000u), __uint_as_float(xw.w << 16), __uint_as_float(xw.w & 0xffff0000u)};
                    const f32x4 v0 = x0 + acc[ai][bj][m][0] * c * gv[bj][0], v1 = x1 + acc[ai][bj][m][1] * c * gv[bj][1];
                    if (FINAL) { float* op = out + grow * 1024 + col0 + bj * HALF; __builtin_nontemporal_store(v0, (f32x4*)op); __builtin_nontemporal_store(v1, (f32x4*)(op + 4)); }
                    else { sq += ((v0[0] * v0[0] + v0[1] * v0[1]) + (v0[2] * v0[2] + v0[3] * v0[3])) + ((v1[0] * v1[0] + v1[1] * v1[1]) + (v1[2] * v1[2] + v1[3] * v1[3]));
                        u32x4 w; w.x = cvt_pk_bf16(v0[0], v0[1]); w.y = cvt_pk_bf16(v0[2], v0[3]); w.z = cvt_pk_bf16(v1[0], v1[1]); w.w = cvt_pk_bf16(v1[2], v1[3]); *(u32x4*)xp = w; }
                }
                if (!FINAL) { sq += __shfl_xor(sq, 16); sq += __shfl_xor(sq, 32); if (fq == 0) P[rl * 4 + wc] = sq; }
            }
        if (!FINAL) {
            asm volatile("s_waitcnt lgkmcnt(0)" ::: "memory"); __builtin_amdgcn_s_barrier(); asm volatile("" ::: "memory");
            if (lane < 32) { const int row = wid * 32 + lane; const f32x4 p = *(const PG8_LAS f32x4*)(P + row * 4); ssp[(size_t)(u.pm * BM + row) * 4 + u.pn] = (p[0] + p[1]) + (p[2] + p[3]); }
        }
    }
};

}

#define GEMM_FUSED(FINAL, AOFF, WOFF, KK, GIN, GOFF, SCALE2, BANK) do { const Args* ap = args_ptr(); \
        pg8::Gemm g{(const bf16_t*)WSP(AOFF), (const bf16_t*)WSP(WS_W + (size_t)l * W_LAYER + (WOFF)), TOK, DM, KK}; pg8::StaticOrder S; S.init(TOK, DM, (int)gridDim.x, (int)blockIdx.x); \
        typedef pg8::EpiNormRes<FINAL, GIN, GOFF, SCALE2, BANK> EpiT; EpiT E; \
        pg8::gemm_phase<EpiT, pg8::StaticOrder, true, true>(ldsl, g, S, E); } while (0)
template <int l> __device__ __forceinline__ void layer_body(unsigned char* lds, LAS unsigned char* ldsl, cg::grid_group& grid) {
        GEMM_PHASE(EpiSwiGLU, WS_H, WO_GU1, 2 * FF, DM, WS_ACT, FF, (const float*)WSP(WS_RS));
        GSYNC();
        GEMM_FUSED(false, WS_ACT, WO_DOWN1, FF, 4, l * DM, 1, 3 * l + 0);
        GSYNC();
        GEMM_PHASE(EpiBf16S, WS_H, WO_IN, NP, DM, WS_PROJ, NP, (const float*)WSP(WS_RS));
        GSYNC();
        _Pragma("nounroll") for (int rm_ = 0; rm_ < REP_MIX; ++rm_) {
#ifndef SKIP_LRU
            { TID_VARS; const Args* ap = args_ptr();
              for (int it = gw; it < NB * 64 * 4; it += NGW)
                lru_local_item(it, lane, lds + wave * 17408, (const bf16_t*)WSP(WS_PROJ), AIN(7) + l * 4 * 256, AIN(8) + l * 256, AIN(9) + l * 16384, AIN(10) + l * 256,
                               AIN(11) + l * 16384, AIN(12) + l * 256, AIN(13) + l * 256, (unsigned*)WSP(WS_PH), (float*)WSP(WS_AGG)); }
#endif
            __syncthreads();
#ifndef SKIP_ATTN
            { TID_VARS; const Args* ap = args_ptr();
              for (int it = bx; it < NB * 2 * 32; it += G) attn_item(it, lds, tid, lane, wave, (const bf16_t*)WSP(WS_PROJ), AIN(14) + l * 8, (bf16_t*)WSP(WS_YMIX)); }
#endif
#ifndef SKIP_CONF
            { TID_VARS; const Args* ap = args_ptr();
              conf_phase(bx, G, lds, tid, lane, wave, (const bf16_t*)WSP(WS_PROJ), AIN(15) + l * 31 * 256, AIN(16) + l * 256, AIN(17) + l * 256, AIN(18) + l * 256, AIN(19) + l * 1024 + 768, (bf16_t*)WSP(WS_YMIX)); }
#endif
        }
        GSYNC();
#ifndef SKIP_MIX2
        { TID_VARS; const Args* ap = args_ptr();
          for (int it = bx; it < NB * 64; it += G) mix2_item(it, lds, tid, lane, wave, (const bf16_t*)WSP(WS_PROJ), (const unsigned*)WSP(WS_PH), (const float*)WSP(WS_AGG), AIN(19) + l * 1024, (bf16_t*)WSP(WS_YMIX)); }
#endif
        GSYNC();
        GEMM_FUSED(false, WS_YMIX, WO_OUT, DM, 21, l * DM, 2, 3 * l + 1);
        GSYNC();
        GEMM_PHASE(EpiSwiGLU, WS_H, WO_GU2, 2 * FF, DM, WS_ACT, FF, (const float*)WSP(WS_RS));
        GSYNC();
        if (l == 0) { GEMM_FUSED(false, WS_ACT, WO_DOWN2, FF, 25, 0, 1, 3 * l + 2); GSYNC(); }
        else GEMM_FUSED(true, WS_ACT, WO_DOWN2, FF, 25, DM, 1, 3 * l + 2);
}

__global__ void __launch_bounds__(NWAVES * 64, 2) hymba_fwd(Args args_unused) {
    extern __shared__ __attribute__((aligned(16))) unsigned char lds[];
    cg::grid_group grid = cg::this_grid();
    LAS unsigned char* ldsl = (LAS unsigned char*)lds;
    if (threadIdx.x < 2) ((volatile LAS unsigned*)(ldsl + MISC_OFF))[threadIdx.x] = 0u;
    if (blockIdx.x == 0) { const Args* ap = args_ptr(); for (int i = threadIdx.x; i < XCD_BAR_WORDS; i += NWAVES * 64) ((unsigned*)WSP(0))[i] = 0u; }
    { const Args* ap = args_ptr(); u32x4* cz = (u32x4*)WSP(WS_SLOTS); for (int i = blockIdx.x * (NWAVES * 64) + threadIdx.x; i < (int)(6 * SLOT_BANK / 16); i += gridDim.x * NWAVES * 64) cz[i] = (u32x4){0u, 0u, 0u, 0u}; }
    __syncthreads();

    _Pragma("nounroll") for (int rp_ = 0; rp_ < REP_P0; ++rp_) {
        TID_VARS; const Args* ap = args_ptr();
        constexpr int I_GU = (DM / 64) * (2 * FF / 64), I_DOWN = (FF / 64) * (DM / 64), I_IN = (DM / 64) * (NP / 64), I_OUT = (DM / 64) * (DM / 64);
        constexpr int I_LAYER = 2 * I_GU + 2 * I_DOWN + I_IN + I_OUT;
        for (int it = gw; it < 2 * I_LAYER; it += NGW) {
            const int l = it / I_LAYER; int r = it % I_LAYER;
            unsigned char* wb = WSP(WS_W + (size_t)l * W_LAYER);
            if (r < I_GU) { transpose_item(AIN(2) + (size_t)l * DM * 2 * FF, DM, 2 * FF, (bf16_t*)(wb + WO_GU1), true, AIN(1) + l * DM, r, lane); continue; } r -= I_GU;
            if (r < I_GU) { transpose_item(AIN(23) + (size_t)l * DM * 2 * FF, DM, 2 * FF, (bf16_t*)(wb + WO_GU2), true, AIN(22) + l * DM, r, lane); continue; } r -= I_GU;
            if (r < I_DOWN) { transpose_item(AIN(3) + (size_t)l * FF * DM, FF, DM, (bf16_t*)(wb + WO_DOWN1), false, nullptr, r, lane); continue; } r -= I_DOWN;
            if (r < I_DOWN) { transpose_item(AIN(24) + (size_t)l * FF * DM, FF, DM, (bf16_t*)(wb + WO_DOWN2), false, nullptr, r, lane); continue; } r -= I_DOWN;
            if (r < I_IN) { transpose_item(AIN(6) + (size_t)l * DM * NP, DM, NP, (bf16_t*)(wb + WO_IN), false, AIN(5) + l * DM, r, lane); continue; } r -= I_IN;
            transpose_item(AIN(20) + (size_t)l * DM * DM, DM, DM, (bf16_t*)(wb + WO_OUT), false, nullptr, r, lane);
        }
        norm_phase<0>(gw, NGW, lane, AIN(0), nullptr, (bf16_t*)WSP(WS_H), nullptr, nullptr, 1.f, (float*)WSP(WS_RS));
    }
    grid.sync();
    if (threadIdx.x == 0) { const Args* ap = args_ptr(); (void)xb_add(&((unsigned*)WSP(0))[XB_XCNT(xb_xcc_id())], 1u); }

    layer_body<0>(lds, ldsl, grid);
    layer_body<1>(lds, ldsl, grid);
}

extern "C" void kernel_launch(void* const* d_in, const int* in_sizes, int n_in, void* d_out, int out_size, void* d_ws, size_t ws_size, hipStream_t stream) {
    static int grid = 0;
    if (grid == 0) {
        if (n_in != 26 || out_size != TOK * DM || ws_size < WS_END) { fprintf(stderr, "kernel_launch: unexpected shapes (n_in %d out %d ws %zu)\n", n_in, out_size, ws_size); grid = -1; return; }
        int dev = 0, cus = 0, per_cu = 0;
        hipGetDevice(&dev);
        hipDeviceGetAttribute(&cus, hipDeviceAttributeMultiprocessorCount, dev);
        hipFuncSetAttribute((const void*)hymba_fwd, hipFuncAttributeMaxDynamicSharedMemorySize, LDS_BYTES);
        hipOccupancyMaxActiveBlocksPerMultiprocessor(&per_cu, (const void*)hymba_fwd, NWAVES * 64, LDS_BYTES);
        if (per_cu < 1) { fprintf(stderr, "kernel_launch: occupancy query says %d blocks/CU\n", per_cu); per_cu = 1; }
        (void)hipGetLastError();
        grid = cus;
    }
    if (grid < 0) return;
    Args a{};
    for (int i = 0; i < 26; ++i) a.in[i] = (const float*)d_in[i];
    a.out = (float*)d_out; a.ws = (unsigned char*)d_ws;
    void* params[] = {&a};
    hipError_t e = hipLaunchCooperativeKernel((const void*)hymba_fwd, dim3(grid), dim3(NWAVES * 64), params, LDS_BYTES, stream);
    if (e != hipSuccess) fprintf(stderr, "cooperative launch failed: %s (grid %d)\n", hipGetErrorString(e), grid);
}
```
